# Optimizing an MI355X kernel written in HIP

```python
import math
import jax, jax.numpy as jnp
from jax import lax
import numpy as np

D_MODEL = 1024
BATCH = 4
SEQ = 4096
DEPTH = 2

HEAD_DIM = 64
A_HEADS = 6
A_WIDTH = A_HEADS * HEAD_DIM
GMLP_CHUNK = 128
POOL_WINDOWS = (2, 4, 8, 16)
B_GROUPS = len(POOL_WINDOWS)
B_GROUP_DIM = 64
B_WIDTH = B_GROUPS * B_GROUP_DIM
DILATED_CONFIGS = ((128, 1), (512, 4), (2048, 16))
C_HEADS_PER_GROUP = 2
C_GROUPS = len(DILATED_CONFIGS)
C_HEADS = C_GROUPS * C_HEADS_PER_GROUP
C_WIDTH = C_HEADS * HEAD_DIM
C_OUT_WIDTH = C_HEADS_PER_GROUP * HEAD_DIM
MIX_WIDTH = A_WIDTH + B_WIDTH + C_WIDTH
IN_WIDTH = 2 * A_WIDTH + B_WIDTH + 3 * C_WIDTH
OUT_WIDTH = A_WIDTH + B_WIDTH + C_OUT_WIDTH
N_BUCKETS = 32
MAX_DISTANCE = 1024
MEM_LEN = 256
X_HEADS = 4
X_HEAD_DIM = D_MODEL // X_HEADS
D_FF = 128 * ((8 * D_MODEL // 3 + 127) // 128)
CONV_WIDTH = 3
EPS = 1e-6
NEG_INF = -1e30

kernel_name = "hybrid_gmlp_pool_dilated_encoder"


def _rmsnorm(x, g):
    x32 = x.astype(jnp.float32)
    y = x32 * lax.rsqrt(jnp.mean(x32 * x32, axis=-1, keepdims=True) + EPS)
    return (y * g.astype(jnp.float32)).astype(x.dtype)


def _t5_bucket(rel):
    nb = N_BUCKETS // 2
    ret = (rel > 0).astype(np.int32) * nb
    n = np.abs(rel)
    max_exact = nb // 2
    large = max_exact + (np.log(np.maximum(n, 1) / max_exact)
                         / math.log(MAX_DISTANCE / max_exact) * (nb - max_exact)).astype(np.int32)
    large = np.minimum(large, nb - 1)
    return ret + np.where(n < max_exact, n, large)


def _spatial_gating(z_uv, v_gain, w_s, b_s):
    B, S, _ = z_uv.shape
    z = jax.nn.gelu(z_uv)
    u, v = jnp.split(z, 2, axis=-1)
    v = _rmsnorm(v.reshape(B, S, A_HEADS, HEAD_DIM), v_gain)
    vc = v.reshape(B, S // GMLP_CHUNK, GMLP_CHUNK, A_HEADS, HEAD_DIM)
    s = jnp.einsum('hpq,bnqhe->bnphe', w_s, vc) + b_s.T[None, None, :, :, None]
    return (u.reshape(B, S, A_HEADS, HEAD_DIM) * s.reshape(B, S, A_HEADS, HEAD_DIM)).reshape(B, S, A_WIDTH)


def _multiscale_pool(z, w_pool, b_pool, pool_scale):
    B, S, _ = z.shape
    cs = jnp.pad(jnp.cumsum(z.astype(jnp.float32), axis=1), ((0, 0), (1, 0), (0, 0)))
    pos = np.arange(S)
    outs = []
    for g, w in enumerate(POOL_WINDOWS):
        lo = np.clip(pos - w // 2, 0, S)
        hi = np.clip(pos + w // 2, 0, S)
        sl = slice(g * B_GROUP_DIM, (g + 1) * B_GROUP_DIM)
        cnt = (hi - lo).astype(np.float32)[None, :, None]
        outs.append((cs[:, hi, sl] - cs[:, lo, sl]) / cnt)
    pooled = jnp.concatenate(outs, axis=-1).astype(z.dtype) - z
    pooled = pooled.reshape(B, S, B_GROUPS, B_GROUP_DIM)
    y = jnp.einsum('bsge,gef->bsgf', pooled, w_pool) + b_pool
    return y.reshape(B, S, B_WIDTH) * pool_scale


def _dilated_window_attention(q, k, v, rel_table_g, dilation, radius):
    B, S, H, E = q.shape
    L = S // dilation
    C = radius
    n_blk = -(-L // C)
    Lp = n_blk * C

    def to_sub(t):
        t = t.reshape(B, L, dilation, H, E).transpose(0, 2, 1, 3, 4)
        return jnp.pad(t, ((0, 0), (0, 0), (0, Lp - L), (0, 0), (0, 0)))

    def band(t):
        t = jnp.pad(to_sub(t), ((0, 0), (0, 0), (C, C), (0, 0), (0, 0))).reshape(B, dilation, n_blk + 2, C, H, E)
        return jnp.concatenate([t[:, :, :-2], t[:, :, 1:-1], t[:, :, 2:]], axis=3)

    qs = to_sub(q).reshape(B, dilation, n_blk, C, H, E)
    kb, vb = band(k), band(v)
    delta = (np.arange(3 * C)[None, :] - C) - np.arange(C)[:, None]
    bias = rel_table_g[_t5_bucket(delta * dilation)].transpose(2, 0, 1)
    key_sub = np.arange(n_blk)[:, None] * C + np.arange(3 * C)[None, :] - C
    valid = ((np.abs(delta) <= radius)[None]
             & ((key_sub >= 0) & (key_sub < L))[:, None, :])
    logits = jnp.einsum('bdnqhe,bdnkhe->bdnhqk', qs, kb).astype(jnp.float32) * (E ** -0.5)
    logits = logits + bias[None, None, None].astype(jnp.float32)
    logits = jnp.where(valid[None, None, :, None], logits, NEG_INF)
    lse = jax.nn.logsumexp(logits, axis=-1)
    p = jnp.exp(logits - lse[..., None]).astype(v.dtype)
    out = jnp.einsum('bdnhqk,bdnkhe->bdnqhe', p, vb).reshape(B, dilation, Lp, H, E)[:, :, :L]
    out = out.transpose(0, 2, 1, 3, 4).reshape(B, S, H, E)
    lse = lse.transpose(0, 1, 2, 4, 3).reshape(B, dilation, Lp, H)[:, :, :L]
    lse = lse.transpose(0, 2, 1, 3).reshape(B, S, H)
    return out, lse


def _hybrid_mixer(h, rel_table, w_in, b_in, v_gain, w_s, b_s, w_pool, b_pool, pool_scale, w_out, b_out):
    B, S, _ = h.shape
    z = h @ w_in + b_in
    za = z[..., :2 * A_WIDTH]
    zb = z[..., 2 * A_WIDTH:2 * A_WIDTH + B_WIDTH]
    zc = z[..., 2 * A_WIDTH + B_WIDTH:]
    ya = _spatial_gating(za, v_gain, w_s, b_s)
    yb = _multiscale_pool(zb, w_pool, b_pool, pool_scale)
    q, k, v = [t.reshape(B, S, C_GROUPS, C_HEADS_PER_GROUP, HEAD_DIM) for t in jnp.split(zc, 3, axis=-1)]
    outs, lses = [], []
    for g, (window, dil) in enumerate(DILATED_CONFIGS):
        o, l = _dilated_window_attention(q[:, :, g], k[:, :, g], v[:, :, g],
                                         rel_table[:, g * C_HEADS_PER_GROUP:(g + 1) * C_HEADS_PER_GROUP],
                                         dil, window // (2 * dil))
        outs.append(o)
        lses.append(l)
    weights = jax.nn.softmax(jnp.stack(lses, axis=0), axis=0)
    yc = jnp.einsum('gbsh,gbshe->bshe', weights, jnp.stack(outs, axis=0).astype(jnp.float32))
    yc = yc.astype(h.dtype).reshape(B, S, C_OUT_WIDTH)
    y = jnp.concatenate([ya, yb, yc], axis=-1)
    return y @ w_out + b_out


def _memory_cross_attention(h, mem_n, w_q, w_kv, w_o, b_o):
    B, S, _ = h.shape
    M = mem_n.shape[1]
    q = (h @ w_q).reshape(B, S, X_HEADS, X_HEAD_DIM)
    k, v = [t.reshape(B, M, X_HEADS, X_HEAD_DIM) for t in jnp.split(mem_n @ w_kv, 2, axis=-1)]
    logits = jnp.einsum('bshe,bmhe->bhsm', q, k).astype(jnp.float32) * (X_HEAD_DIM ** -0.5)
    p = jax.nn.softmax(logits, axis=-1).astype(v.dtype)
    o = jnp.einsum('bhsm,bmhe->bshe', p, v).reshape(B, S, D_MODEL)
    return o @ w_o + b_o


def _conv_ffn(h, w_up, b_up, conv_w, conv_b, w_down, b_down):
    S = h.shape[1]
    u = h @ w_up + b_up
    up = jnp.pad(u, ((0, 0), (1, 1), (0, 0)))
    u = conv_w[0] * up[:, :S] + conv_w[1] * up[:, 1:S + 1] + conv_w[2] * up[:, 2:] + conv_b
    gate, val = jnp.split(u, 2, axis=-1)
    return (jax.nn.silu(gate) * val) @ w_down + b_down


def setup_inputs(seed: int = 0) -> dict:
    key = jax.random.key(seed)
    ks = iter(jax.random.split(key, 40))
    f32 = jnp.float32

    def nrm(shape, scale):
        return jax.random.normal(next(ks), shape, f32) * scale

    L = DEPTH
    return {
        "x": nrm((BATCH, SEQ, D_MODEL), 1.0),
        "mem": nrm((BATCH, MEM_LEN, D_MODEL), 1.0),
        "rel_table": nrm((N_BUCKETS, C_HEADS), 0.5),
        "mem_norm_g": 1.0 + nrm((D_MODEL,), 0.02),
        "norm_mix_g": 1.0 + nrm((L, D_MODEL), 0.02),
        "w_in": nrm((L, D_MODEL, IN_WIDTH), D_MODEL ** -0.5),
        "b_in": nrm((L, IN_WIDTH), 0.02),
        "gmlp_v_g": 1.0 + nrm((L, A_HEADS, HEAD_DIM), 0.02),
        "gmlp_w_s": nrm((L, A_HEADS, GMLP_CHUNK, GMLP_CHUNK), GMLP_CHUNK ** -0.5),
        "gmlp_b_s": 1.0 + nrm((L, A_HEADS, GMLP_CHUNK), 0.02),
        "pool_w": nrm((L, B_GROUPS, B_GROUP_DIM, B_GROUP_DIM), B_GROUP_DIM ** -0.5),
        "pool_b": nrm((L, B_GROUPS, B_GROUP_DIM), 0.02),
        "pool_scale": 1.0 + nrm((L, B_WIDTH), 0.1),
        "w_out": nrm((L, OUT_WIDTH, D_MODEL), OUT_WIDTH ** -0.5),
        "b_out": nrm((L, D_MODEL), 0.02),
        "norm_mem_g": 1.0 + nrm((L, D_MODEL), 0.02),
        "xattn_w_q": nrm((L, D_MODEL, D_MODEL), D_MODEL ** -0.5),
        "xattn_w_kv": nrm((L, D_MODEL, 2 * D_MODEL), D_MODEL ** -0.5),
        "xattn_w_o": nrm((L, D_MODEL, D_MODEL), D_MODEL ** -0.5),
        "xattn_b_o": nrm((L, D_MODEL), 0.02),
        "norm_ffn_g": 1.0 + nrm((L, D_MODEL), 0.02),
        "ffn_w_up": nrm((L, D_MODEL, 2 * D_FF), D_MODEL ** -0.5),
        "ffn_b_up": nrm((L, 2 * D_FF), 0.02),
        "ffn_conv_w": jnp.array([0.25, 0.5, 0.25], f32)[None, :, None] + nrm((L, CONV_WIDTH, 2 * D_FF), 0.1),
        "ffn_conv_b": nrm((L, 2 * D_FF), 0.02),
        "ffn_w_down": nrm((L, D_FF, D_MODEL), D_FF ** -0.5),
        "ffn_b_down": nrm((L, D_MODEL), 0.02),
        "final_norm_g": 1.0 + nrm((D_MODEL,), 0.02),
    }


def reference(x, mem, rel_table, mem_norm_g, norm_mix_g, w_in, b_in, gmlp_v_g, gmlp_w_s, gmlp_b_s,
              pool_w, pool_b, pool_scale, w_out, b_out, norm_mem_g, xattn_w_q, xattn_w_kv, xattn_w_o,
              xattn_b_o, norm_ffn_g, ffn_w_up, ffn_b_up, ffn_conv_w, ffn_conv_b, ffn_w_down, ffn_b_down,
              final_norm_g):
    mem_n = _rmsnorm(mem, mem_norm_g)
    for l in range(DEPTH):
        h = _rmsnorm(x, norm_mix_g[l])
        x = x + _hybrid_mixer(h, rel_table, w_in[l], b_in[l], gmlp_v_g[l], gmlp_w_s[l], gmlp_b_s[l],
                              pool_w[l], pool_b[l], pool_scale[l], w_out[l], b_out[l])
        h = _rmsnorm(x, norm_mem_g[l])
        x = x + _memory_cross_attention(h, mem_n, xattn_w_q[l], xattn_w_kv[l], xattn_w_o[l], xattn_b_o[l])
        h = _rmsnorm(x, norm_ffn_g[l])
        x = x + _conv_ffn(h, ffn_w_up[l], ffn_b_up[l], ffn_conv_w[l], ffn_conv_b[l], ffn_w_down[l], ffn_b_down[l])
    return _rmsnorm(x, final_norm_g)
```

```cpp
#include <hip/hip_runtime.h>
#include <cstdio>
#include <cstdint>

#ifndef MK_PER_PHASE
#define MK_PER_PHASE 1
#endif

#define LAS __attribute__((address_space(3)))
#define GAS __attribute__((address_space(1)))
typedef unsigned short bf16;
typedef short bf16x8 __attribute__((ext_vector_type(8)));
typedef float f32x4 __attribute__((ext_vector_type(4)));
typedef float f32x2 __attribute__((ext_vector_type(2)));
typedef unsigned u32x4 __attribute__((ext_vector_type(4)));
typedef unsigned u32x2 __attribute__((ext_vector_type(2)));

constexpr int NBATCH = 4, SEQ = 4096, DM = 1024, TOK = NBATCH * SEQ;
constexpr int INW = 2176, INWP = 2304, OUTW = 768, DFF = 2816, DFF2 = 5632, MEML = 256, MEMR = NBATCH * MEML;
constexpr float EPS = 1e-6f;
constexpr float LOG2E = 1.4426950408889634f;

constexpr size_t MiB = 1u << 20;
constexpr size_t WS_CTL = 0, CTL_ZERO_BYTES = 1 * MiB;
constexpr size_t WS_SSQ = 1 * MiB;
constexpr size_t WS_TAB = 2 * MiB;
constexpr size_t WS_W = 3 * MiB;
constexpr size_t WL_WIN = 0, WL_WOUT = 4608 * 1024, WL_WUP = WL_WOUT + 1536 * 1024, WL_WDOWN = WL_WUP + 11 * MiB, WL_QKT = WL_WDOWN + 5632 * 1024, WL_VOT = WL_QKT + 8 * MiB, WL_STRIDE = WL_VOT + 8 * MiB;
static_assert(WL_STRIDE == 38 * MiB + 512 * 1024, "weights per layer");
constexpr size_t WS_XB = 80 * MiB;
constexpr size_t WS_TR = 112 * MiB;
constexpr size_t WS_Z = WS_TR, WS_Y = WS_TR + 72 * MiB;
constexpr size_t WS_P = WS_TR;
constexpr size_t WS_G = WS_TR, WS_UQ = WS_TR + 88 * MiB;
constexpr size_t WS_WQ = WS_TR + 96 * MiB, WS_WKVT = WS_WQ + 4 * MiB, WS_WOT = WS_WKVT + 8 * MiB, WS_MEMN = WS_WOT + 4 * MiB, WS_KV = WS_MEMN + 2 * MiB, WS_END = WS_KV + 8 * MiB;
static_assert(WS_END <= 256 * MiB && WS_W + 2 * WL_STRIDE <= WS_XB && WS_UQ + (size_t)SEQ * DFF2 * 2 <= 256 * MiB, "ws map");

constexpr int RING_BYTES = 131072, XL_OFF = 131072, LDSCTL_OFF = 139264, MISC_OFF = LDSCTL_OFF + 320, LDS_BYTES = 147456;

namespace pg8 {
constexpr int BM = 256, BK = 64, HALF = 128, HTB = HALF * BK * 2, STAGE_BYTES = 8 * HTB, NXCD = 8, WGM = 8;
__host__ __device__ __forceinline__ int lds_byte(int r, int c) { const int st = (r >> 4) * 2 + (c >> 5), rr = r & 15, cc = c & 31, ob = rr * 64 + cc * 2; return st * 1024 + (ob ^ (((ob >> 9) & 1) << 5)); }
__host__ __device__ __forceinline__ void stage_rc(int b, int& R, int& C) { const int st = b / 1024, sb = b % 1024, swz = sb ^ (((sb >> 9) & 1) << 5); R = (st >> 1) * 16 + swz / 64; C = (st & 1) * 32 + (swz % 64) / 2; }
__host__ __device__ __forceinline__ int perm32(int rho) { const int n = rho >> 4, i = rho & 15; return 8 * (i >> 2) + 4 * n + (i & 3); }

struct Unit { int pm, pn; };
struct OpMap { int sh_m, mk_m, sh_n, mk_n; int c_mhi, c_mlo, c_nhi, c_nlo;
    __device__ __forceinline__ long long off(const Unit& u) const { return (long long)((u.pm >> sh_m) * c_mhi + (u.pm & mk_m) * c_mlo + (u.pn >> sh_n) * c_nhi + (u.pn & mk_n) * c_nlo); } };
struct Gemm { const bf16* A; const bf16* Bt; int K, lda, ldb; OpMap ma, mb; };
__device__ __forceinline__ OpMap map_rows(int ld) { OpMap m{0, 0, 0, 0, 0, 0, 0, 0}; m.c_mhi = 256 * ld; return m; }
__device__ __forceinline__ OpMap map_cols(int ld) { OpMap m{0, 0, 0, 0, 0, 0, 0, 0}; m.c_nhi = 256 * ld; return m; }

struct StaticOrder {
    int nM, nN, nwg, G, c;
    __device__ void init(int nM_, int nN_, int G_, int c_) { nM = nM_; nN = nN_; nwg = nM * nN; G = G_; c = c_; }
    __device__ bool next(int i, Unit& u) const {
        const long L = (long)i * G + c; if (L >= nwg) return false;
        int wgid = (int)L; { const int q = nwg / NXCD, r = nwg % NXCD, xcd = wgid % NXCD, off = wgid / NXCD; wgid = (xcd < r ? xcd * (q + 1) : r * (q + 1) + (xcd - r) * q) + off; }
        const int nig = WGM * nN, gid = wgid / nig, fm = gid * WGM, gsz = (nM - fm) < WGM ? (nM - fm) : WGM;
        u.pm = fm + ((wgid % nig) % gsz); u.pn = (wgid % nig) / gsz; return true;
    }
};

__device__ __forceinline__ unsigned cvt_pk_bf16(float lo, float hi) { unsigned r; asm volatile("v_cvt_pk_bf16_f32 %0, %1, %2" : "=v"(r) : "v"(lo), "v"(hi)); return r; }

__device__ __forceinline__ void rstd8(const float* ssq, int row0  , int fq, float (&rs)[2][4], float mul) {
    f32x4 p[2][4];
#pragma unroll
    for (int ai = 0; ai < 2; ++ai)
#pragma unroll
        for (int m = 0; m < 4; ++m) p[ai][m] = *(const GAS f32x4*)(ssq + (size_t)(row0 + ai * HALF + m * 16) * 16 + fq * 4);
#pragma unroll
    for (int ai = 0; ai < 2; ++ai)
#pragma unroll
        for (int m = 0; m < 4; ++m) { float s = (p[ai][m][0] + p[ai][m][1]) + (p[ai][m][2] + p[ai][m][3]); s += __shfl_xor(s, 16); s += __shfl_xor(s, 32);
            rs[ai][m] = mul / sqrtf(s * (1.0f / DM) + EPS); }
}
struct EpiRowBf16 {
    static constexpr bool PERM = true;
    bf16* O; int ldc; const float* bias; const float* ssq; int ssq_row_off; float cscale;
    __device__ __forceinline__ void operator()(f32x4 (&acc)[2][2][4][2], const Unit& u, int wr, int wc, int fr, int fq, LAS unsigned char*, int, int) const {
        const int rowt = u.pm * BM + wr * 64 + fr, col0 = u.pn * BM + wc * 32 + 8 * fq;
        float rs[2][4];
        if (ssq) rstd8(ssq, ssq_row_off + rowt, fq, rs, cscale);
        else {
#pragma unroll
            for (int ai = 0; ai < 2; ++ai)
#pragma unroll
                for (int m = 0; m < 4; ++m) rs[ai][m] = cscale; }
        f32x4 bv[2][2];
#pragma unroll
        for (int bj = 0; bj < 2; ++bj)
#pragma unroll
            for (int n = 0; n < 2; ++n) bv[bj][n] = bias ? *(const GAS f32x4*)(bias + col0 + bj * HALF + 4 * n) : (f32x4){0.f, 0.f, 0.f, 0.f};
#pragma unroll
        for (int ai = 0; ai < 2; ++ai)
#pragma unroll
            for (int m = 0; m < 4; ++m) { bf16* rowp = O + (size_t)(rowt + ai * HALF + m * 16) * ldc + col0; const float r = rs[ai][m];
#pragma unroll
                for (int bj = 0; bj < 2; ++bj) { const f32x4 v0 = acc[ai][bj][m][0] * r + bv[bj][0], v1 = acc[ai][bj][m][1] * r + bv[bj][1];
                    u32x4 w; w.x = cvt_pk_bf16(v0[0], v0[1]); w.y = cvt_pk_bf16(v0[2], v0[3]); w.z = cvt_pk_bf16(v1[0], v1[1]); w.w = cvt_pk_bf16(v1[2], v1[3]);
                    *(GAS u32x4*)(rowp + bj * HALF) = w; } }
    }
};
struct EpiSoftmax {
    static constexpr bool PERM = true;
    bf16* P; const float* ssq;
    __device__ __forceinline__ void operator()(f32x4 (&acc)[2][2][4][2], const Unit& u, int wr, int wc, int fr, int fq, LAS unsigned char* xl, int, int) const {
        const int rowt = u.pm * BM + wr * 64 + fr, col0 = u.pn * BM + wc * 32 + 8 * fq;
        LAS f32x2* X = (LAS f32x2*)xl;
        float ml[2][4], rs[2][4];
        rstd8(ssq, rowt, fq, rs, 1.0f);
#pragma unroll
        for (int ai = 0; ai < 2; ++ai)
#pragma unroll
            for (int m = 0; m < 4; ++m) {
                const float r = rs[ai][m];
                float mx = -3.0e38f;
#pragma unroll
                for (int bj = 0; bj < 2; ++bj)
#pragma unroll
                    for (int n = 0; n < 2; ++n) { f32x4 v = acc[ai][bj][m][n] * r; acc[ai][bj][m][n] = v; mx = fmaxf(fmaxf(fmaxf(v[0], v[1]), fmaxf(v[2], v[3])), mx); }
                mx = fmaxf(mx, __shfl_xor(mx, 16)); mx = fmaxf(mx, __shfl_xor(mx, 32));
                float l = 0.f;
#pragma unroll
                for (int bj = 0; bj < 2; ++bj)
#pragma unroll
                    for (int n = 0; n < 2; ++n) { f32x4 v = acc[ai][bj][m][n]; v[0] = __builtin_amdgcn_exp2f(v[0] - mx); v[1] = __builtin_amdgcn_exp2f(v[1] - mx); v[2] = __builtin_amdgcn_exp2f(v[2] - mx); v[3] = __builtin_amdgcn_exp2f(v[3] - mx);
                        acc[ai][bj][m][n] = v; l += (v[0] + v[1]) + (v[2] + v[3]); }
                l += __shfl_xor(l, 16); l += __shfl_xor(l, 32);
                ml[ai][m] = mx;
                if (fq == 0) X[(ai * HALF + wr * 64 + m * 16 + fr) * 4 + wc] = (f32x2){mx, l};
            }
        asm volatile("s_waitcnt lgkmcnt(0)" ::: "memory"); __builtin_amdgcn_s_barrier(); asm volatile("" ::: "memory");
#pragma unroll
        for (int ai = 0; ai < 2; ++ai)
#pragma unroll
            for (int m = 0; m < 4; ++m) {
                const LAS f32x2* xr = X + (ai * HALF + wr * 64 + m * 16 + fr) * 4;
                const f32x2 a = xr[0], b = xr[1], c = xr[2], d = xr[3];
                const float M = fmaxf(fmaxf(a.x, b.x), fmaxf(c.x, d.x));
                const float L = (a.y * __builtin_amdgcn_exp2f(a.x - M) + b.y * __builtin_amdgcn_exp2f(b.x - M)) + (c.y * __builtin_amdgcn_exp2f(c.x - M) + d.y * __builtin_amdgcn_exp2f(d.x - M));
                const float f = __builtin_amdgcn_exp2f(ml[ai][m] - M) / L;
                bf16* rowp = P + (size_t)(rowt + ai * HALF + m * 16) * DM + col0;
#pragma unroll
                for (int bj = 0; bj < 2; ++bj) { const f32x4 v0 = acc[ai][bj][m][0] * f, v1 = acc[ai][bj][m][1] * f;
                    u32x4 w; w.x = cvt_pk_bf16(v0[0], v0[1]); w.y = cvt_pk_bf16(v0[2], v0[3]); w.z = cvt_pk_bf16(v1[0], v1[1]); w.w = cvt_pk_bf16(v1[2], v1[3]);
                    *(GAS u32x4*)(rowp + bj * HALF) = w; }
            }
    }
};
struct EpiResidual {
    static constexpr bool PERM = false;
    const float* xold; float* xnew; bf16* xb; const float* bias; float* ssq;
    __device__ __forceinline__ void operator()(f32x4 (&acc)[2][2][4][2], const Unit& u, int wr, int wc, int fr, int fq, LAS unsigned char*, int, int) const {
        const int row0 = u.pm * BM + wr * 64 + fr, col0 = u.pn * BM + wc * 32 + 4 * fq;
        f32x4 bv[2][2];
#pragma unroll
        for (int bj = 0; bj < 2; ++bj)
#pragma unroll
            for (int n = 0; n < 2; ++n) bv[bj][n] = *(const GAS f32x4*)(bias + col0 + bj * HALF + n * 16);
#pragma unroll
        for (int ai = 0; ai < 2; ++ai)
#pragma unroll
            for (int m = 0; m < 4; ++m) { int row = row0 + ai * HALF + m * 16; asm volatile("" : "+v"(row)); const size_t off = (size_t)row * DM + col0; float sq = 0.f;
#pragma unroll
                for (int bj = 0; bj < 2; ++bj)
#pragma unroll
                    for (int n = 0; n < 2; ++n) { const f32x4 xo = *(const GAS f32x4*)(xold + off + bj * HALF + n * 16); const f32x4 v = (acc[ai][bj][m][n] + bv[bj][n]) + xo;
                        *(GAS f32x4*)(xnew + off + bj * HALF + n * 16) = v; sq += (v[0] * v[0] + v[1] * v[1]) + (v[2] * v[2] + v[3] * v[3]);
                        u32x2 w; w.x = cvt_pk_bf16(v[0], v[1]); w.y = cvt_pk_bf16(v[2], v[3]); *(GAS u32x2*)(xb + off + bj * HALF + n * 16) = w; }
                sq += __shfl_xor(sq, 16); sq += __shfl_xor(sq, 32);
                if (fq == 0) *(GAS float*)(ssq + (size_t)row * 16 + u.pn * 4 + wc) = sq;
                asm volatile("" ::: "memory"); }
    }
};

template <class Epi, class Sched>
__device__ __forceinline__ void gemm_phase(LAS unsigned char* lds, LAS unsigned char* xl, const Gemm g, const Sched& S, const Epi& E, const int tid) {
    const int wid = __builtin_amdgcn_readfirstlane(tid >> 6), lane = tid & 63, wr = wid >> 2, wc = wid & 3, fr = lane & 15, fq = lane >> 4;
    const int K = g.K, nt = K / BK;
    unsigned voffA[2], voffB[2];
#pragma unroll
    for (int i = 0; i < 2; ++i) { int R, C; stage_rc(tid * 16 + i * 8192, R, C); const int Rb = Epi::PERM ? ((R & ~31) + perm32(R & 31)) : R;
        voffA[i] = (unsigned)(R * g.lda + C) * 2u; voffB[i] = (unsigned)(Rb * g.ldb + C) * 2u; }
    const size_t kstep = (size_t)(BK * 2);
    const size_t hstepA = (size_t)HALF * g.lda * 2, hstepB = (size_t)HALF * g.ldb * 2;
    const unsigned ldsw = (unsigned)wid * 1024u;
    const int aoff = lds_byte(wr * 64 + fr, fq * 8), boff = lds_byte(wc * 32 + fr, fq * 8);
#define PG8_SA(b, h) (((b) * 2 + (h)) * HTB)
#define PG8_SB(b, h) ((4 + (b) * 2 + (h)) * HTB)
#define PG8_STAGE(bufoff, gbase, voff) do { _Pragma("unroll") for (int _i = 0; _i < 2; ++_i) \
        __builtin_amdgcn_global_load_lds((const unsigned*)((const char*)(gbase) + (voff)[_i]), (LAS unsigned*)(lds + (bufoff) + ldsw + _i * 8192), 16, 0, 0); } while (0)
#define PG8_LDA(dst, b, h) do { _Pragma("unroll") for (int m = 0; m < 4; ++m) _Pragma("unroll") for (int k = 0; k < 2; ++k) dst[m][k] = *(const LAS bf16x8*)(lds + PG8_SA(b, h) + aoff + m * 2048 + k * 1024); } while (0)
#define PG8_LDB(dst, b, h) do { _Pragma("unroll") for (int n = 0; n < 2; ++n) _Pragma("unroll") for (int k = 0; k < 2; ++k) dst[n][k] = *(const LAS bf16x8*)(lds + PG8_SB(b, h) + boff + n * 2048 + k * 1024); } while (0)
#define PG8_MMA(ai, bj, At, Bt) do { __builtin_amdgcn_s_setprio(1); _Pragma("unroll") for (int m = 0; m < 4; ++m) _Pragma("unroll") for (int n = 0; n < 2; ++n) _Pragma("unroll") for (int k = 0; k < 2; ++k) \
        acc[ai][bj][m][n] = __builtin_amdgcn_mfma_f32_16x16x32_bf16(Bt[n][k], At[m][k], acc[ai][bj][m][n], 0, 0, 0); __builtin_amdgcn_s_setprio(0); } while (0)
#define PG8_WAIT_V(n) asm volatile("s_waitcnt vmcnt(" #n ")" ::: "memory")
#define PG8_WAIT_L(n) asm volatile("s_waitcnt lgkmcnt(" #n ")" ::: "memory")
#define PG8_BAR __builtin_amdgcn_s_barrier()
#define PG8_SCHED __builtin_amdgcn_sched_barrier(0)
    Unit cur, nxt; int ui = 0;
    if (!S.next(0, cur)) return;
    f32x4 acc[2][2][4][2];
#pragma unroll
    for (int a = 0; a < 2; ++a)
#pragma unroll
        for (int b = 0; b < 2; ++b)
#pragma unroll
            for (int m = 0; m < 4; ++m)
#pragma unroll
                for (int n = 0; n < 2; ++n) acc[a][b][m][n] = (f32x4){0.f, 0.f, 0.f, 0.f};
    bf16x8 At[4][2], B0[2][2], B1[2][2];
    const char* cA = (const char*)(g.A + g.ma.off(cur)); const char* cB = (const char*)(g.Bt + g.mb.off(cur));
    PG8_STAGE(PG8_SB(0, 0), cB, voffB); PG8_STAGE(PG8_SB(0, 1), cB + hstepB, voffB); PG8_STAGE(PG8_SA(0, 0), cA, voffA); PG8_STAGE(PG8_SA(0, 1), cA + hstepA, voffA);
    if (wr == 1) PG8_BAR;
    PG8_WAIT_V(2); PG8_BAR;
    PG8_STAGE(PG8_SB(1, 0), cB + kstep, voffB); PG8_STAGE(PG8_SA(1, 0), cA + kstep, voffA); PG8_STAGE(PG8_SB(1, 1), cB + hstepB + kstep, voffB);
    PG8_WAIT_V(6); PG8_BAR;
    for (;;) {
        const bool has_next = S.next(ui + 1, nxt);
        const char* nA = has_next ? (const char*)(g.A + g.ma.off(nxt)) : cA; const char* nB = has_next ? (const char*)(g.Bt + g.mb.off(nxt)) : cB;
        for (int t = 0; t < nt; t += 2) {
            const bool last = (t == nt - 2);
            const char* a1 = cA + (size_t)(t + 1) * kstep;
            const char* a2 = last ? nA : cA + (size_t)(t + 2) * kstep; const char* b2 = last ? nB : cB + (size_t)(t + 2) * kstep;
            const char* a3 = a2 + kstep; const char* b3 = b2 + kstep;
            PG8_LDB(B0, 0, 0); PG8_LDB(B1, 0, 1); PG8_SCHED; PG8_LDA(At, 0, 0); PG8_STAGE(PG8_SA(1, 1), a1 + hstepA, voffA);
            PG8_WAIT_V(8); PG8_WAIT_L(0); PG8_BAR; PG8_MMA(0, 0, At, B0); PG8_MMA(0, 1, At, B1); PG8_BAR; PG8_SCHED;
            PG8_LDA(At, 0, 1); PG8_STAGE(PG8_SB(0, 0), b2, voffB); PG8_STAGE(PG8_SB(0, 1), b2 + hstepB, voffB); PG8_STAGE(PG8_SA(0, 0), a2, voffA);
            PG8_WAIT_V(8); PG8_WAIT_L(0); PG8_BAR; PG8_MMA(1, 0, At, B0); PG8_MMA(1, 1, At, B1); PG8_BAR; PG8_SCHED;
            PG8_LDB(B0, 1, 0); PG8_LDB(B1, 1, 1); PG8_SCHED; PG8_LDA(At, 1, 0); PG8_STAGE(PG8_SA(0, 1), a2 + hstepA, voffA);
            PG8_WAIT_V(8); PG8_WAIT_L(0); PG8_BAR; PG8_MMA(0, 0, At, B0); PG8_MMA(0, 1, At, B1); PG8_BAR; PG8_SCHED;
            PG8_LDA(At, 1, 1); PG8_STAGE(PG8_SB(1, 0), b3, voffB); PG8_STAGE(PG8_SB(1, 1), b3 + hstepB, voffB); PG8_STAGE(PG8_SA(1, 0), a3, voffA);
            PG8_WAIT_V(8); PG8_WAIT_L(0); PG8_BAR; PG8_MMA(1, 0, At, B0); PG8_MMA(1, 1, At, B1); PG8_BAR; PG8_SCHED;
        }
        if (wr == 0) PG8_BAR;
        { int fr_ = fr, fq_ = fq, lane_ = lane; asm volatile("" : "+v"(fr_), "+v"(fq_), "+v"(lane_));
          E(acc, cur, wr, wc, fr_, fq_, xl, wid, lane_); }
        if (!has_next) break;
#pragma unroll
        for (int a = 0; a < 2; ++a)
#pragma unroll
            for (int b = 0; b < 2; ++b)
#pragma unroll
                for (int m = 0; m < 4; ++m)
#pragma unroll
                    for (int n = 0; n < 2; ++n) acc[a][b][m][n] = (f32x4){0.f, 0.f, 0.f, 0.f};
        cur = nxt; cA = nA; cB = nB; ++ui;
        if (wr == 1) PG8_BAR;
    }
    PG8_WAIT_V(0);
    PG8_BAR;
#undef PG8_SA
#undef PG8_SB
#undef PG8_STAGE
#undef PG8_LDA
#undef PG8_LDB
#undef PG8_MMA
#undef PG8_WAIT_V
#undef PG8_WAIT_L
#undef PG8_BAR
#undef PG8_SCHED
}
}

typedef GAS unsigned gu32;
#define RLX_AGENT __ATOMIC_RELAXED, __HIP_MEMORY_SCOPE_AGENT
#define LDS_WAIT() asm volatile("s_waitcnt lgkmcnt(0)" ::: "memory")
#define VM_WAIT() asm volatile("s_waitcnt vmcnt(0)" ::: "memory")
__device__ __forceinline__ unsigned f2bf(float f) { unsigned u = __builtin_bit_cast(unsigned, f); return (u + 0x7fffu + ((u >> 16) & 1u)) >> 16; }
__device__ __forceinline__ unsigned pk2(float lo, float hi) { return f2bf(lo) | (f2bf(hi) << 16); }
__device__ __forceinline__ float bf2f(unsigned short h) { return __builtin_bit_cast(float, (unsigned)h << 16); }
__device__ __forceinline__ float bflo(unsigned w) { return __builtin_bit_cast(float, w << 16); }
__device__ __forceinline__ float bfhi(unsigned w) { return __builtin_bit_cast(float, w & 0xffff0000u); }
__device__ __forceinline__ float wave_sum(float v) {
#pragma unroll
    for (int o = 1; o < 64; o <<= 1) v += __shfl_xor(v, o);
    return v;
}
__device__ __forceinline__ float wave_max(float v) {
#pragma unroll
    for (int o = 1; o < 64; o <<= 1) v = fmaxf(v, __shfl_xor(v, o));
    return v;
}
__device__ __forceinline__ float gelu_tanh(float x) { const float u = 0.7978845608028654f * (x + 0.044715f * x * x * x); return x / (1.0f + __expf(-2.0f * u)); }
__device__ __forceinline__ float silu(float x) { return x / (1.0f + __expf(-x)); }

#define XB_TMO      128
#define XB_XCNT(j)  (256  + 64 * (j))
#define XB_XSUB(j)  (1280 + 64 * (j))
#define XB_XGEN(j)  (2304 + 64 * (j))
#define XB_TOP      3328
#define XB_TOPGEN   3392
#define XCD_BAR_WORDS 3456
#define XB_SPIN_CAP (1u << 18)
__device__ __forceinline__ unsigned xb_ld(unsigned* p)              { return __hip_atomic_load(p, __ATOMIC_RELAXED, __HIP_MEMORY_SCOPE_AGENT); }
__device__ __forceinline__ unsigned xb_add(unsigned* p, unsigned v) { return __hip_atomic_fetch_add(p, v, __ATOMIC_RELAXED, __HIP_MEMORY_SCOPE_AGENT); }
__device__ __forceinline__ unsigned xb_xcc_id() { return (unsigned)__builtin_amdgcn_s_getreg((3 << 11) | 20) & 0xFu; }
#define XB_SPIN(cond, bar) do { unsigned _sp = 0; while (cond) { __builtin_amdgcn_s_sleep(1); \
    if ((++_sp & 255u) == 0u) { if (xb_ld(&(bar)[XB_TMO])) break; if (_sp > XB_SPIN_CAP) { atomicAdd(&(bar)[XB_TMO], 1u); break; } } } } while (0)
struct XcdBarrier { unsigned* bar; unsigned x; volatile LAS unsigned* st; };
__device__ __forceinline__ XcdBarrier xcd_barrier_post(unsigned* bar, volatile LAS unsigned* st) {
    XcdBarrier b; b.bar = bar; b.x = xb_xcc_id(); b.st = st;
    if (threadIdx.x == 0) (void)xb_add(&bar[XB_XCNT(b.x)], 1u);
    return b;
}
__device__ __forceinline__ void xcd_barrier_complete(unsigned* bar, unsigned x, unsigned& nloc, unsigned& nx) {
    const unsigned G = gridDim.x * gridDim.y * gridDim.z;
    unsigned sum, cnt, mine, sp = 0u;
    for (;;) {
        sum = 0u; cnt = 0u; mine = 0u;
#pragma unroll
        for (unsigned j = 0; j < 16; ++j) { const unsigned c = xb_ld(&bar[XB_XCNT(j)]); sum += c; cnt += (c > 0u) ? 1u : 0u; mine = (j == x) ? c : mine; }
        if (sum == G) break;
        __builtin_amdgcn_s_sleep(1);
        if ((++sp & 255u) == 0u) { if (xb_ld(&bar[XB_TMO])) break; if (sp > XB_SPIN_CAP) { atomicAdd(&bar[XB_TMO], 1u); break; } }
    }
    nloc = mine > 0u ? mine : 1u; nx = cnt > 0u ? cnt : 1u;
}
__device__ __forceinline__ void xcd_barrier(const XcdBarrier& b) {
    asm volatile("s_waitcnt vmcnt(0)" ::: "memory");
    __syncthreads();
    if (threadIdx.x == 0) {
        unsigned* bar = b.bar;
        __builtin_amdgcn_s_waitcnt(0);
        unsigned nloc = b.st[0], nx = b.st[1];
        if (nloc == 0u) { xcd_barrier_complete(bar, b.x, nloc, nx); b.st[0] = nloc; b.st[1] = nx; }
        const unsigned old = xb_add(&bar[XB_XSUB(b.x)], 1u);
        const unsigned gen = old / nloc;
        if (old + 1u == (gen + 1u) * nloc) {
            __builtin_amdgcn_fence(__ATOMIC_RELEASE, "agent");
            asm volatile("s_waitcnt vmcnt(0)" ::: "memory");
            const unsigned og = xb_add(&bar[XB_TOP], 1u);
            const unsigned tg = og / nx;
            if (og + 1u == (tg + 1u) * nx) xb_add(&bar[XB_TOPGEN], 1u);
            else XB_SPIN(xb_ld(&bar[XB_TOPGEN]) == tg, bar);
            __builtin_amdgcn_fence(__ATOMIC_ACQUIRE, "agent");
            xb_add(&bar[XB_XGEN(b.x)], 1u);
            asm volatile("s_waitcnt vmcnt(0)" ::: "memory");
        } else {
            XB_SPIN(xb_ld(&bar[XB_XGEN(b.x)]) == gen, bar);
            __builtin_amdgcn_fence(__ATOMIC_ACQUIRE, "agent");
            asm volatile("s_waitcnt vmcnt(0)" ::: "memory");
        }
    }
    __syncthreads();
}

enum { I_X = 0, I_MEM, I_REL, I_MEMG, I_NMIXG, I_WIN, I_BIN, I_VG, I_WS, I_BS, I_PW, I_PB, I_PSC, I_WOUT, I_BOUT, I_NMEMG, I_WQ, I_WKV, I_WO, I_BO, I_NFFNG, I_WUP, I_BUP, I_CW, I_CB, I_WDOWN, I_BDOWN, I_FNG, N_IN };
struct Args { const float* in[N_IN]; float* out; unsigned char* ws; int ph_lo, ph_hi; };
constexpr int PH_PRO = 0, PH_KV = 1, PH_QV = 2, PH_L0 = 3, PH_PER_LAYER = 14, PH_FINAL = PH_L0 + 2 * PH_PER_LAYER, N_PHASES = PH_FINAL + 1;

struct Ctx {
    LAS unsigned char* lds; int tid, lane, wave, G, bid;
    const float* const* in; float* out; unsigned char* ws;
    __device__ __forceinline__ bf16* wl(int l, size_t off) const { return (bf16*)(ws + WS_W + (size_t)l * WL_STRIDE + off); }
};

__device__ __forceinline__ void tr_item(const float* W, int ldw, const float* gain, bf16* WT, int K, int k0, int n0, int drow0, LAS float* scr, int lane) {
#pragma unroll 8
    for (int i = 0; i < 32; ++i) { const int kk = 2 * i + (lane >> 5); float v = W[(size_t)(k0 + kk) * ldw + n0 + (lane & 31)]; if (gain) v *= gain[k0 + kk]; scr[kk * 33 + (lane & 31)] = v; }
    LDS_WAIT(); asm volatile("" ::: "memory");
    const int c = lane & 7;
#pragma unroll
    for (int j = 0; j < 4; ++j) { const int n = (lane >> 3) + 8 * j; const LAS float* s = scr + (8 * c) * 33 + n;
        u32x4 o; o.x = pk2(s[0 * 33], s[1 * 33]); o.y = pk2(s[2 * 33], s[3 * 33]); o.z = pk2(s[4 * 33], s[5 * 33]); o.w = pk2(s[6 * 33], s[7 * 33]);
        *(u32x4*)(WT + (size_t)(drow0 + n) * K + k0 + 8 * c) = o; }
    LDS_WAIT(); asm volatile("" ::: "memory");
}
__device__ __forceinline__ void phase_prologue(const Ctx& C) {
    LAS float* scr = (LAS float*)(C.lds + C.wave * 16384);
    const int gw = C.bid * 8 + C.wave, NGW = C.G * 8, lane = C.lane;
    constexpr int I_IN = 16 * 68, I_OUT = 12 * 32, I_KV = 16 * 64, I_O = 16 * 32, I_UP = 16 * 176, I_DN = 44 * 32, I_L = I_IN + I_OUT + I_KV + I_O + I_UP + I_DN;
    for (int it = gw; it < 2 * I_L; it += NGW) {
        const int l = it / I_L; int r = it % I_L;
        if (r < I_IN) { const int kb = r / 68, nb = r % 68; tr_item(C.in[I_WIN] + (size_t)l * DM * INW, INW, C.in[I_NMIXG] + l * DM, C.wl(l, WL_WIN), DM, kb * 64, nb * 32, nb * 32, scr, lane); continue; } r -= I_IN;
        if (r < I_OUT) { const int kb = r / 32, nb = r % 32; tr_item(C.in[I_WOUT] + (size_t)l * OUTW * DM, DM, nullptr, C.wl(l, WL_WOUT), OUTW, kb * 64, nb * 32, nb * 32, scr, lane); continue; } r -= I_OUT;
        if (r < I_KV) { const int kb = r / 64, nb = r % 64; tr_item(C.in[I_WKV] + (size_t)l * DM * 2048, 2048, nullptr, (bf16*)(C.ws + WS_WKVT) + (size_t)l * 2048 * DM, DM, kb * 64, nb * 32, nb * 32, scr, lane); continue; } r -= I_KV;
        if (r < I_O) { const int kb = r / 32, nb = r % 32; tr_item(C.in[I_WO] + (size_t)l * DM * DM, DM, nullptr, (bf16*)(C.ws + WS_WOT) + (size_t)l * DM * DM, DM, kb * 64, nb * 32, nb * 32, scr, lane); continue; } r -= I_O;
        if (r < I_UP) { const int kb = r / 176, nb = r % 176; const int n0 = nb * 32; const int drow = n0 < DFF ? (n0 / 128) * 256 + (n0 % 128) : ((n0 - DFF) / 128) * 256 + 128 + ((n0 - DFF) % 128);
            tr_item(C.in[I_WUP] + (size_t)l * DM * DFF2, DFF2, C.in[I_NFFNG] + l * DM, C.wl(l, WL_WUP), DM, kb * 64, n0, drow, scr, lane); continue; } r -= I_UP;
        { const int kb = r / 32, nb = r % 32; tr_item(C.in[I_WDOWN] + (size_t)l * DFF * DM, DM, nullptr, C.wl(l, WL_WDOWN), DFF, kb * 64, nb * 32, nb * 32, scr, lane); }
    }
    for (int i = gw * 64 + lane; i < 2 * (INWP - INW) * DM / 8; i += NGW * 64) { const int l = i / ((INWP - INW) * DM / 8), j = i % ((INWP - INW) * DM / 8);
        *((u32x4*)(C.wl(l, WL_WIN) + (size_t)INW * DM) + j) = (u32x4){0u, 0u, 0u, 0u}; }
    for (int r = gw; r < 2 * DM; r += NGW) { const int l = r / DM, k = r % DM; const float gk = C.in[I_NMEMG][l * DM + k];
        const f32x4* src = (const f32x4*)(C.in[I_WQ] + (size_t)l * DM * DM + (size_t)k * DM); u32x2* dst = (u32x2*)((bf16*)(C.ws + WS_WQ) + (size_t)l * DM * DM + (size_t)k * DM);
#pragma unroll
        for (int j = 0; j < 4; ++j) { const f32x4 v = src[lane + 64 * j] * gk; u32x2 w; w.x = pk2(v[0], v[1]); w.y = pk2(v[2], v[3]); dst[lane + 64 * j] = w; } }
    for (int r = gw; r < TOK; r += NGW) { const f32x4* src = (const f32x4*)(C.in[I_X] + (size_t)r * DM); u32x2* dst = (u32x2*)((bf16*)(C.ws + WS_XB) + (size_t)r * DM); float s = 0.f;
#pragma unroll
        for (int j = 0; j < 4; ++j) { const f32x4 v = src[lane + 64 * j]; s += (v[0] * v[0] + v[1] * v[1]) + (v[2] * v[2] + v[3] * v[3]); u32x2 w; w.x = pk2(v[0], v[1]); w.y = pk2(v[2], v[3]); dst[lane + 64 * j] = w; }
        s = wave_sum(s); if (lane < 16) ((float*)(C.ws + WS_SSQ))[(size_t)r * 16 + lane] = lane == 0 ? s : 0.f; }
    for (int r = gw; r < MEMR; r += NGW) { const f32x4* src = (const f32x4*)(C.in[I_MEM] + (size_t)r * DM); const f32x4* gg = (const f32x4*)C.in[I_MEMG]; u32x2* dst = (u32x2*)((bf16*)(C.ws + WS_MEMN) + (size_t)r * DM);
        f32x4 v[4]; float s = 0.f;
#pragma unroll
        for (int j = 0; j < 4; ++j) { v[j] = src[lane + 64 * j]; s += (v[j][0] * v[j][0] + v[j][1] * v[j][1]) + (v[j][2] * v[j][2] + v[j][3] * v[j][3]); }
        const float rs = 1.0f / sqrtf(wave_sum(s) * (1.0f / DM) + EPS);
#pragma unroll
        for (int j = 0; j < 4; ++j) { const f32x4 o = v[j] * rs * gg[lane + 64 * j]; u32x2 w; w.x = pk2(o[0], o[1]); w.y = pk2(o[2], o[3]); dst[lane + 64 * j] = w; } }
    float* tab = (float*)(C.ws + WS_TAB);
    for (int i = C.bid * 512 + C.tid; i < 2 * INWP; i += C.G * 512) { const int l = i / INWP, c = i % INWP; tab[i] = c < INW ? C.in[I_BIN][l * INW + c] : 0.f; }
    for (int i = C.bid * 512 + C.tid; i < 2 * DFF2; i += C.G * 512) { const int l = i / DFF2, c = i % DFF2; const int t = c >> 8, w = c & 255; const int src = w < 128 ? t * 128 + w : DFF + t * 128 + (w - 128);
        tab[2 * INWP + i] = C.in[I_BUP][l * DFF2 + src]; }
}

__device__ __forceinline__ int t5_bucket(int rel) {
    const int n = rel < 0 ? -rel : rel; int b = rel > 0 ? 16 : 0;
    if (n < 8) return b + n;
    return b + 8 + (n >= 15) + (n >= 27) + (n >= 50) + (n >= 91) + (n >= 166) + (n >= 305) + (n >= 559);
}
__device__ __forceinline__ void phase_mixer(const Ctx& C, int l) {
    const bf16* z = (const bf16*)(C.ws + WS_Z); bf16* y = (bf16*)(C.ws + WS_Y);
    const int lane = C.lane, wave = C.wave, tid = C.tid;
    {
        LAS float* vn = (LAS float*)C.lds;
        const float* ws_ = C.in[I_WS] + (size_t)l * 6 * 128 * 128; const float* bs_ = C.in[I_BS] + l * 6 * 128; const float* vg = C.in[I_VG] + l * 6 * 64;
        for (int uu = C.bid; uu < NBATCH * 32 * 6; uu += C.G) {
            const int h = uu % 6, n = (uu / 6) % 32, b = uu / 192; const size_t r0 = (size_t)b * SEQ + n * 128;
            for (int i = 0; i < 16; ++i) { const int q = wave * 16 + i; const float val = gelu_tanh(bf2f(z[(r0 + q) * INWP + 384 + h * 64 + lane]));
                const float ss = wave_sum(val * val); vn[q * 64 + lane] = val * (1.0f / sqrtf(ss * (1.0f / 64) + EPS)) * vg[h * 64 + lane]; }
            __syncthreads();
            float vcol[128];
#pragma unroll
            for (int q = 0; q < 128; ++q) vcol[q] = vn[q * 64 + lane];
            for (int i = 0; i < 16; ++i) { const int p = wave * 16 + i; const float* wrow = ws_ + ((size_t)h * 128 + p) * 128; float a = 0.f;
#pragma unroll
                for (int q = 0; q < 128; ++q) a += wrow[q] * vcol[q];
                const float u = gelu_tanh(bf2f(z[(r0 + p) * INWP + h * 64 + lane]));
                y[(r0 + p) * OUTW + h * 64 + lane] = (bf16)f2bf(u * (a + bs_[h * 128 + p])); }
            __syncthreads();
        }
    }
    {
        LAS float* pl = (LAS float*)(C.lds + 32768);
        const float* pw = C.in[I_PW] + (size_t)l * 4 * 64 * 64; const float* pb = C.in[I_PB] + l * 256; const float* psc = C.in[I_PSC] + l * 256;
        for (int uu = C.bid; uu < TOK / 32; uu += C.G) {
            const int r0 = uu * 32; const int c = tid & 255, g = c >> 6, hw = 1 << g;
            for (int i = 0; i < 16; ++i) { const int t = (tid >> 8) * 16 + i; const int row = r0 + t, pos = row & (SEQ - 1), base = row - pos;
                const int lo = pos - hw < 0 ? 0 : pos - hw, hi = pos + hw > SEQ ? SEQ : pos + hw; float s = 0.f;
                for (int p = lo; p < hi; ++p) s += bf2f(z[(size_t)(base + p) * INWP + 768 + c]);
                pl[t * 256 + c] = s / (float)(hi - lo) - bf2f(z[(size_t)row * INWP + 768 + c]); }
            __syncthreads();
            const int f = c & 63; float a16[16];
#pragma unroll
            for (int i = 0; i < 16; ++i) a16[i] = 0.f;
            const float* wp = pw + (g * 64) * 64 + f; const LAS float* plr = pl + (tid >> 8) * 16 * 256 + g * 64;
#pragma unroll 2
            for (int e = 0; e < 64; ++e) { const float w = wp[e * 64];
#pragma unroll
                for (int i = 0; i < 16; ++i) a16[i] += plr[i * 256 + e] * w; }
#pragma unroll
            for (int i = 0; i < 16; ++i) { const int t = (tid >> 8) * 16 + i; y[(size_t)(r0 + t) * OUTW + 384 + c] = (bf16)f2bf((a16[i] + pb[c]) * psc[c]); }
            __syncthreads();
        }
    }
    {
        LAS float* tab = (LAS float*)(C.lds + 73728);
        LAS float* qs = (LAS float*)(C.lds + 65536) + wave * 256;
        LAS float* ps = qs + 64;
        for (int i = tid; i < 3 * 2 * 129; i += 512) { const int j = i % 129 - 64, gh = i / 129, g = gh >> 1; const int d = g == 0 ? 1 : (g == 1 ? 4 : 16);
            tab[i] = C.in[I_REL][t5_bucket(j * d) * 6 + gh]; }
        __syncthreads();
        for (int uu = C.bid; uu < TOK / 4; uu += C.G) {
            const int row = uu * 4 + (wave >> 1), h = wave & 1, pos = row & (SEQ - 1), base = row - pos;
            float m = -3.0e38f, lsum = 0.f, acc = 0.f;
            for (int g = 0; g < 3; ++g) {
                const int d = g == 0 ? 1 : (g == 1 ? 4 : 16);
                qs[lane] = bf2f(z[(size_t)row * INWP + 1024 + g * 128 + h * 64 + lane]) * 0.125f;
                float lg[3];
#pragma unroll
                for (int rd = 0; rd < 3; ++rd) { const int jj = lane + 64 * rd, kp = pos + d * (jj - 64); const bool ok = jj <= 128 && kp >= 0 && kp < SEQ; float s = -1.0e30f;
                    if (ok) { const u32x4* kr = (const u32x4*)(z + (size_t)(base + kp) * INWP + 1408 + g * 128 + h * 64); s = 0.f;
#pragma unroll
                        for (int c8 = 0; c8 < 8; ++c8) { const u32x4 kv = kr[c8]; const LAS float* qq = qs + c8 * 8;
                            s += qq[0] * bflo(kv.x) + qq[1] * bfhi(kv.x) + qq[2] * bflo(kv.y) + qq[3] * bfhi(kv.y) + qq[4] * bflo(kv.z) + qq[5] * bfhi(kv.z) + qq[6] * bflo(kv.w) + qq[7] * bfhi(kv.w); }
                        s += tab[(g * 2 + h) * 129 + jj]; }
                    lg[rd] = s; }
                const float mg = wave_max(fmaxf(fmaxf(lg[0], lg[1]), lg[2])); const float mn = fmaxf(m, mg); const float sc = __expf(m - mn);
                acc *= sc; lsum *= sc; m = mn; float psum = 0.f;
#pragma unroll
                for (int rd = 0; rd < 3; ++rd) { const float p = lg[rd] > -1.0e29f ? __expf(lg[rd] - mn) : 0.f; ps[lane + 64 * rd] = p; psum += p; }
                lsum += wave_sum(psum);
                const bf16* vb = z + 1792 + g * 128 + h * 64 + lane;
                for (int jj = 0; jj <= 128; ++jj) { const float p = ps[jj]; int kp = pos + d * (jj - 64); kp = kp < 0 ? 0 : (kp >= SEQ ? SEQ - 1 : kp);
                    acc += p * bf2f(vb[(size_t)(base + kp) * INWP]); }
            }
            y[(size_t)row * OUTW + 640 + h * 64 + lane] = (bf16)f2bf(acc / lsum);
        }
        __syncthreads();
    }
}

__device__ __forceinline__ void phase_conv(const Ctx& C, int l, int qd) {
    const bf16* uq = (const bf16*)(C.ws + WS_UQ); bf16* gout = (bf16*)(C.ws + WS_G) + (size_t)qd * SEQ * DFF;
    const float* cw = C.in[I_CW] + (size_t)l * 3 * DFF2; const float* cb = C.in[I_CB] + (size_t)l * DFF2;
    const int NI = SEQ * (DFF / 8);
    for (int i = C.bid * 512 + C.tid; i < NI; i += C.G * 512) {
        const int row = i / (DFF / 8), c8 = (i % (DFF / 8)) * 8; const int t = c8 >> 7, w = c8 & 127;
        const bf16* pg = uq + (size_t)row * DFF2 + t * 256 + w; const bf16* pv = pg + 128;
        const u32x4 zero = (u32x4){0u, 0u, 0u, 0u};
        const u32x4 g0 = row > 0 ? *(const u32x4*)(pg - DFF2) : zero, g1 = *(const u32x4*)pg, g2 = row < SEQ - 1 ? *(const u32x4*)(pg + DFF2) : zero;
        const u32x4 v0 = row > 0 ? *(const u32x4*)(pv - DFF2) : zero, v1 = *(const u32x4*)pv, v2 = row < SEQ - 1 ? *(const u32x4*)(pv + DFF2) : zero;
        float o[8];
#pragma unroll
        for (int e = 0; e < 8; ++e) { const int cg = c8 + e, cv = DFF + c8 + e;
            const unsigned a0 = g0[e >> 1], a1 = g1[e >> 1], a2 = g2[e >> 1], b0 = v0[e >> 1], b1 = v1[e >> 1], b2 = v2[e >> 1];
            const float ga = (e & 1) ? bfhi(a0) : bflo(a0), gb = (e & 1) ? bfhi(a1) : bflo(a1), gc = (e & 1) ? bfhi(a2) : bflo(a2);
            const float va = (e & 1) ? bfhi(b0) : bflo(b0), vb = (e & 1) ? bfhi(b1) : bflo(b1), vc = (e & 1) ? bfhi(b2) : bflo(b2);
            const float gt = cw[cg] * ga + cw[DFF2 + cg] * gb + cw[2 * DFF2 + cg] * gc + cb[cg];
            const float vl = cw[cv] * va + cw[DFF2 + cv] * vb + cw[2 * DFF2 + cv] * vc + cb[cv];
            o[e] = silu(gt) * vl; }
        u32x4 w4; w4.x = pk2(o[0], o[1]); w4.y = pk2(o[2], o[3]); w4.z = pk2(o[4], o[5]); w4.w = pk2(o[6], o[7]);
        *(u32x4*)(gout + (size_t)row * DFF + c8) = w4;
    }
}

__device__ __forceinline__ void phase_final(const Ctx& C) {
    const int gw = C.bid * 8 + C.wave, NGW = C.G * 8, lane = C.lane; const f32x4* gg = (const f32x4*)C.in[I_FNG];
    for (int r = gw; r < TOK; r += NGW) { f32x4* xr = (f32x4*)(C.out + (size_t)r * DM); f32x4 v[4]; float s = 0.f;
#pragma unroll
        for (int j = 0; j < 4; ++j) { v[j] = xr[lane + 64 * j]; s += (v[j][0] * v[j][0] + v[j][1] * v[j][1]) + (v[j][2] * v[j][2] + v[j][3] * v[j][3]); }
        const float rs = 1.0f / sqrtf(wave_sum(s) * (1.0f / DM) + EPS);
#pragma unroll
        for (int j = 0; j < 4; ++j) xr[lane + 64 * j] = v[j] * rs * gg[lane + 64 * j]; }
}

__global__ void __launch_bounds__(512, 2) enc_fwd(Args args) {
    extern __shared__ __attribute__((aligned(16))) unsigned char lds_raw[];
    LAS unsigned char* const lds0 = (LAS unsigned char*)lds_raw;
    volatile LAS unsigned* MISC = (volatile LAS unsigned*)(lds0 + MISC_OFF);
    for (int u = threadIdx.x; u < (LDS_BYTES - LDSCTL_OFF) / 4; u += 512) ((LAS unsigned*)(lds0 + LDSCTL_OFF))[u] = 0u;
    __syncthreads();
    XcdBarrier bar; bar.bar = (unsigned*)(args.ws + WS_CTL) + 4096; bar.x = 0; bar.st = nullptr;
    const int lo = args.ph_lo, hi = args.ph_hi;
    const int wave_s = __builtin_amdgcn_readfirstlane(threadIdx.x >> 6);
    if (hi - lo > 1) bar = xcd_barrier_post((unsigned*)(args.ws + WS_CTL) + 4096, MISC + 8);

    for (int ph = lo; ph < hi; ++ph) {
        if (ph > lo) xcd_barrier(bar);
        unsigned zero_ = 0u; asm volatile("" : "+v"(zero_));
        int tid_ = wave_s * 64 + (int)__builtin_amdgcn_mbcnt_hi(~0u, __builtin_amdgcn_mbcnt_lo(~0u, zero_));
        unsigned char* ws_ = args.ws; asm volatile("" : "+s"(ws_));
        float* out_ = args.out; asm volatile("" : "+s"(out_));
        Ctx C; C.lds = lds0; C.tid = tid_; C.lane = tid_ & 63; C.wave = wave_s; C.G = gridDim.x; C.bid = blockIdx.x;
        C.in = args.in; C.out = out_; C.ws = ws_;
        LAS unsigned char* ring = C.lds; LAS unsigned char* xl = C.lds + XL_OFF;
        const int G = C.G, bid = C.bid;
        float* ssq = (float*)(C.ws + WS_SSQ); const float* tab = (const float*)(C.ws + WS_TAB);
        bf16* xb = (bf16*)(C.ws + WS_XB);
        if (ph == PH_PRO) { phase_prologue(C); continue; }
        if (ph == PH_FINAL) { phase_final(C); continue; }
        int kind = 0; pg8::Gemm g{}; pg8::StaticOrder S{}; pg8::EpiRowBf16 E0{}; pg8::EpiSoftmax E1{}; pg8::EpiResidual E2{};
        int njobs = 1;
        const int lph = (ph - PH_L0) % PH_PER_LAYER, l = ph >= PH_L0 ? (ph - PH_L0) / PH_PER_LAYER : 0;
        if (ph == PH_KV) njobs = 2; else if (ph == PH_QV) njobs = 4;
        else if (lph == 1) { phase_mixer(C, l); continue; }
        else if (lph >= 5 && lph <= 12 && ((lph - 5) & 1)) { phase_conv(C, l, (lph - 5) >> 1); continue; }
        for (int job = 0; job < njobs; ++job) {
            if (ph == PH_KV) {
                const int ll = job;
                g.A = (const bf16*)(C.ws + WS_MEMN); g.Bt = (const bf16*)(C.ws + WS_WKVT) + (size_t)ll * 2048 * DM; g.K = DM; g.lda = DM; g.ldb = DM; g.ma = pg8::map_rows(DM); g.mb = pg8::map_cols(DM);
                S.init(4, 8, G, (bid + G - 32 * job) % G);
                kind = 0; E0 = pg8::EpiRowBf16{(bf16*)(C.ws + WS_KV) + (size_t)ll * MEMR * 2048, 2048, nullptr, nullptr, 0, 1.0f};
            } else if (ph == PH_QV) {
                const int ll = job >> 1; const bf16* KV = (const bf16*)(C.ws + WS_KV) + (size_t)ll * MEMR * 2048;
                if ((job & 1) == 0) {
                    g.A = KV; g.lda = 2048; g.ma = pg8::OpMap{2, 3, 0, 0, 256 * 2048, 256, 0, 0};
                    g.Bt = (const bf16*)(C.ws + WS_WQ) + (size_t)ll * DM * DM; g.ldb = DM; g.mb = pg8::OpMap{0, 3, 0, 0, 0, 256, 256 * DM, 0}; g.K = 256;
                    S.init(16, 4, G, (bid + G - 64 * job) % G);
                    kind = 0; E0 = pg8::EpiRowBf16{C.wl(ll, WL_QKT), DM, nullptr, nullptr, 0, 0.0625f * LOG2E};
                } else {
                    g.A = (const bf16*)(C.ws + WS_WOT) + (size_t)ll * DM * DM; g.lda = DM; g.ma = pg8::OpMap{0, 0, 0, 3, 256 * DM, 0, 0, 256};
                    g.Bt = KV + 1024; g.ldb = 2048; g.mb = pg8::OpMap{0, 0, 2, 3, 0, 0, 256 * 2048, 256}; g.K = 256;
                    S.init(4, 16, G, (bid + G - 64 * job) % G);
                    kind = 0; E0 = pg8::EpiRowBf16{C.wl(ll, WL_VOT), 4096, nullptr, nullptr, 0, 1.0f};
                }
            } else if (lph == 0) {
                g.A = xb; g.Bt = C.wl(l, WL_WIN); g.K = DM; g.lda = DM; g.ldb = DM; g.ma = pg8::map_rows(DM); g.mb = pg8::map_cols(DM);
                S.init(64, 9, G, bid); kind = 0; E0 = pg8::EpiRowBf16{(bf16*)(C.ws + WS_Z), INWP, tab + l * INWP, ssq, 0, 1.0f};
            } else if (lph == 2) {
                g.A = (const bf16*)(C.ws + WS_Y); g.Bt = C.wl(l, WL_WOUT); g.K = OUTW; g.lda = OUTW; g.ldb = OUTW; g.ma = pg8::map_rows(OUTW); g.mb = pg8::map_cols(OUTW);
                S.init(64, 4, G, bid); kind = 2; E2 = pg8::EpiResidual{l == 0 ? C.in[I_X] : C.out, C.out, xb, C.in[I_BOUT] + l * DM, ssq};
            } else if (lph == 3) {
                g.A = xb; g.Bt = C.wl(l, WL_QKT); g.K = DM; g.lda = DM; g.ldb = DM; g.ma = pg8::map_rows(DM); g.mb = pg8::OpMap{4, 0, 0, 0, 1024 * 1024, 0, 256 * DM, 0};
                S.init(64, 4, G, bid); kind = 1; E1 = pg8::EpiSoftmax{(bf16*)(C.ws + WS_P), ssq};
            } else if (lph == 4) {
                g.A = (const bf16*)(C.ws + WS_P); g.Bt = C.wl(l, WL_VOT); g.K = DM; g.lda = DM; g.ldb = 4096; g.ma = pg8::map_rows(DM); g.mb = pg8::OpMap{4, 0, 0, 0, 1024, 0, 256 * 4096, 0};
                S.init(64, 4, G, bid); kind = 2; E2 = pg8::EpiResidual{C.out, C.out, xb, C.in[I_BO] + l * DM, ssq};
            } else if (lph >= 5 && lph <= 12) {
                const int qd = (lph - 5) >> 1; g.A = xb + (size_t)qd * SEQ * DM; g.Bt = C.wl(l, WL_WUP); g.K = DM; g.lda = DM; g.ldb = DM; g.ma = pg8::map_rows(DM); g.mb = pg8::map_cols(DM);
                S.init(16, 22, G, bid); kind = 0; E0 = pg8::EpiRowBf16{(bf16*)(C.ws + WS_UQ), DFF2, tab + 2 * INWP + l * DFF2, ssq, qd * SEQ, 1.0f};
            } else {
                g.A = (const bf16*)(C.ws + WS_G); g.Bt = C.wl(l, WL_WDOWN); g.K = DFF; g.lda = DFF; g.ldb = DFF; g.ma = pg8::map_rows(DFF); g.mb = pg8::map_cols(DFF);
                S.init(64, 4, G, bid); kind = 2; E2 = pg8::EpiResidual{C.out, C.out, xb, C.in[I_BDOWN] + l * DM, ssq};
            }
            if (kind == 0) pg8::gemm_phase<pg8::EpiRowBf16, pg8::StaticOrder>(ring, xl, g, S, E0, C.tid);
            else if (kind == 1) pg8::gemm_phase<pg8::EpiSoftmax, pg8::StaticOrder>(ring, xl, g, S, E1, C.tid);
            else pg8::gemm_phase<pg8::EpiResidual, pg8::StaticOrder>(ring, xl, g, S, E2, C.tid);
        }
    }
}

extern "C" void kernel_launch(void* const* d_in, const int* in_sizes, int n_in, void* d_out, int out_size, void* d_ws, size_t ws_size, hipStream_t stream) {
    static int grid = 0;
    if (grid == 0) {
        if (n_in != N_IN || in_sizes[0] != TOK * DM || out_size != TOK * DM || ws_size < 256 * MiB) { fprintf(stderr, "kernel_launch: unexpected shapes (n_in %d, in0 %d, out %d, ws %zu)\n", n_in, n_in > 0 ? in_sizes[0] : -1, out_size, ws_size); grid = -1; return; }
        int dev = 0, cus = 0, per_cu = 0;
        if (hipGetDevice(&dev) != hipSuccess || hipDeviceGetAttribute(&cus, hipDeviceAttributeMultiprocessorCount, dev) != hipSuccess) { grid = -1; return; }
        if (hipFuncSetAttribute((const void*)enc_fwd, hipFuncAttributeMaxDynamicSharedMemorySize, LDS_BYTES) != hipSuccess) { fprintf(stderr, "kernel_launch: hipFuncSetAttribute failed\n"); grid = -1; return; }
        if (hipOccupancyMaxActiveBlocksPerMultiprocessor(&per_cu, (const void*)enc_fwd, 512, LDS_BYTES) != hipSuccess || per_cu < 1) fprintf(stderr, "kernel_launch: occupancy query says %d\n", per_cu);
        (void)hipGetLastError();
        grid = cus;
    }
    if (grid < 0) return;
    if (hipMemsetAsync((char*)d_ws + WS_CTL, 0, CTL_ZERO_BYTES, stream) != hipSuccess) return;
    Args a{};
    for (int i = 0; i < N_IN; ++i) a.in[i] = (const float*)d_in[i];
    a.out = (float*)d_out; a.ws = (unsigned char*)d_ws;
#if MK_PER_PHASE
    for (int ph = 0; ph < N_PHASES; ++ph) { a.ph_lo = ph; a.ph_hi = ph + 1; hipLaunchKernelGGL(enc_fwd, dim3(grid), dim3(512), LDS_BYTES, stream, a); }
#else
    a.ph_lo = 0; a.ph_hi = N_PHASES; hipLaunchKernelGGL(enc_fwd, dim3(grid), dim3(512), LDS_BYTES, stream, a);
#endif
}
```

```cpp
#include <hip/hip_runtime.h>
#include <cstdio>
#include <cstdint>

#ifndef MK_PER_PHASE
#define MK_PER_PHASE 0
#endif

#define LAS __attribute__((address_space(3)))
#define GAS __attribute__((address_space(1)))
typedef unsigned short bf16;
typedef short bf16x8 __attribute__((ext_vector_type(8)));
typedef float f32x4 __attribute__((ext_vector_type(4)));
typedef float f32x2 __attribute__((ext_vector_type(2)));
typedef unsigned u32x4 __attribute__((ext_vector_type(4)));
typedef unsigned u32x2 __attribute__((ext_vector_type(2)));

constexpr int NBATCH = 4, SEQ = 4096, DM = 1024, TOK = NBATCH * SEQ;
constexpr int INW = 2176, INWP = 2304, OUTW = 768, DFF = 2816, DFF2 = 5632, MEML = 256, MEMR = NBATCH * MEML;
constexpr float EPS = 1e-6f;
constexpr float LOG2E = 1.4426950408889634f;

constexpr size_t MiB = 1u << 20;
constexpr size_t WS_CTL = 0, CTL_ZERO_BYTES = 1 * MiB;
constexpr size_t WS_SSQ = 1 * MiB;
constexpr size_t WS_TAB = 2 * MiB;
constexpr size_t WS_W = 3 * MiB;
constexpr size_t WL_WIN = 0, WL_WOUT = 4608 * 1024, WL_WUP = WL_WOUT + 1536 * 1024, WL_WDOWN = WL_WUP + 11 * MiB, WL_QKT = WL_WDOWN + 5632 * 1024, WL_VOT = WL_QKT + 8 * MiB, WL_STRIDE = WL_VOT + 8 * MiB;
static_assert(WL_STRIDE == 38 * MiB + 512 * 1024, "weights per layer");
constexpr size_t WS_XB = 80 * MiB;
constexpr size_t WS_TR = 112 * MiB;
constexpr size_t WS_Z = WS_TR, WS_Y = WS_TR + 72 * MiB;
constexpr size_t WS_P = WS_TR;
constexpr size_t WS_G = WS_TR, WS_UQ = WS_TR + 88 * MiB;
constexpr size_t WS_WQ = WS_TR + 96 * MiB, WS_WKVT = WS_WQ + 4 * MiB, WS_WOT = WS_WKVT + 8 * MiB, WS_MEMN = WS_WOT + 4 * MiB, WS_KV = WS_MEMN + 2 * MiB, WS_END = WS_KV + 8 * MiB;
static_assert(WS_END <= 256 * MiB && WS_W + 2 * WL_STRIDE <= WS_XB && WS_UQ + (size_t)SEQ * DFF2 * 2 <= 256 * MiB, "ws map");

constexpr int RING_BYTES = 131072, XL_OFF = 131072, LDSCTL_OFF = 139264, MISC_OFF = LDSCTL_OFF + 320, LDS_BYTES = 147456;

namespace pg8 {
constexpr int BM = 256, BK = 64, HALF = 128, HTB = HALF * BK * 2, STAGE_BYTES = 8 * HTB, NXCD = 8, WGM = 8;
__host__ __device__ __forceinline__ int lds_byte(int r, int c) { const int st = (r >> 4) * 2 + (c >> 5), rr = r & 15, cc = c & 31, ob = rr * 64 + cc * 2; return st * 1024 + (ob ^ (((ob >> 9) & 1) << 5)); }
__host__ __device__ __forceinline__ void stage_rc(int b, int& R, int& C) { const int st = b / 1024, sb = b % 1024, swz = sb ^ (((sb >> 9) & 1) << 5); R = (st >> 1) * 16 + swz / 64; C = (st & 1) * 32 + (swz % 64) / 2; }
__host__ __device__ __forceinline__ int perm32(int rho) { const int n = rho >> 4, i = rho & 15; return 8 * (i >> 2) + 4 * n + (i & 3); }

struct Unit { int pm, pn; };
struct OpMap { int sh_m, mk_m, sh_n, mk_n; int c_mhi, c_mlo, c_nhi, c_nlo;
    __device__ __forceinline__ long long off(const Unit& u) const { return (long long)((u.pm >> sh_m) * c_mhi + (u.pm & mk_m) * c_mlo + (u.pn >> sh_n) * c_nhi + (u.pn & mk_n) * c_nlo); } };
struct Gemm { const bf16* A; const bf16* Bt; int K, lda, ldb; OpMap ma, mb; };
__device__ __forceinline__ OpMap map_rows(int ld) { OpMap m{0, 0, 0, 0, 0, 0, 0, 0}; m.c_mhi = 256 * ld; return m; }
__device__ __forceinline__ OpMap map_cols(int ld) { OpMap m{0, 0, 0, 0, 0, 0, 0, 0}; m.c_nhi = 256 * ld; return m; }

struct StaticOrder {
    int nM, nN, nwg, G, c;
    __device__ void init(int nM_, int nN_, int G_, int c_) { nM = nM_; nN = nN_; nwg = nM * nN; G = G_; c = c_; }
    __device__ bool next(int i, Unit& u) const {
        const long L = (long)i * G + c; if (L >= nwg) return false;
        int wgid = (int)L; { const int q = nwg / NXCD, r = nwg % NXCD, xcd = wgid % NXCD, off = wgid / NXCD; wgid = (xcd < r ? xcd * (q + 1) : r * (q + 1) + (xcd - r) * q) + off; }
        const int nig = WGM * nN, gid = wgid / nig, fm = gid * WGM, gsz = (nM - fm) < WGM ? (nM - fm) : WGM;
        u.pm = fm + ((wgid % nig) % gsz); u.pn = (wgid % nig) / gsz; return true;
    }
};

__device__ __forceinline__ unsigned cvt_pk_bf16(float lo, float hi) { unsigned r; asm volatile("v_cvt_pk_bf16_f32 %0, %1, %2" : "=v"(r) : "v"(lo), "v"(hi)); return r; }

__device__ __forceinline__ void rstd8(const float* ssq, int row0  , int fq, float (&rs)[2][4], float mul) {
    f32x4 p[2][4];
#pragma unroll
    for (int ai = 0; ai < 2; ++ai)
#pragma unroll
        for (int m = 0; m < 4; ++m) p[ai][m] = *(const GAS f32x4*)(ssq + (size_t)(row0 + ai * HALF + m * 16) * 16 + fq * 4);
#pragma unroll
    for (int ai = 0; ai < 2; ++ai)
#pragma unroll
        for (int m = 0; m < 4; ++m) { float s = (p[ai][m][0] + p[ai][m][1]) + (p[ai][m][2] + p[ai][m][3]); s += __shfl_xor(s, 16); s += __shfl_xor(s, 32);
            rs[ai][m] = mul / sqrtf(s * (1.0f / DM) + EPS); }
}
struct EpiRowBf16 {
    static constexpr bool PERM = true;
    bf16* O; int ldc; const float* bias; const float* ssq; int ssq_row_off; float cscale;
    __device__ __forceinline__ void operator()(f32x4 (&acc)[2][2][4][2], const Unit& u, int wr, int wc, int fr, int fq, LAS unsigned char*, int, int) const {
        const int rowt = u.pm * BM + wr * 64 + fr, col0 = u.pn * BM + wc * 32 + 8 * fq;
        float rs[2][4];
        if (ssq) rstd8(ssq, ssq_row_off + rowt, fq, rs, cscale);
        else {
#pragma unroll
            for (int ai = 0; ai < 2; ++ai)
#pragma unroll
                for (int m = 0; m < 4; ++m) rs[ai][m] = cscale; }
        f32x4 bv[2][2];
#pragma unroll
        for (int bj = 0; bj < 2; ++bj)
#pragma unroll
            for (int n = 0; n < 2; ++n) bv[bj][n] = bias ? *(const GAS f32x4*)(bias + col0 + bj * HALF + 4 * n) : (f32x4){0.f, 0.f, 0.f, 0.f};
#pragma unroll
        for (int ai = 0; ai < 2; ++ai)
#pragma unroll
            for (int m = 0; m < 4; ++m) { bf16* rowp = O + (size_t)(rowt + ai * HALF + m * 16) * ldc + col0; const float r = rs[ai][m];
#pragma unroll
                for (int bj = 0; bj < 2; ++bj) { const f32x4 v0 = acc[ai][bj][m][0] * r + bv[bj][0], v1 = acc[ai][bj][m][1] * r + bv[bj][1];
                    u32x4 w; w.x = cvt_pk_bf16(v0[0], v0[1]); w.y = cvt_pk_bf16(v0[2], v0[3]); w.z = cvt_pk_bf16(v1[0], v1[1]); w.w = cvt_pk_bf16(v1[2], v1[3]);
                    *(GAS u32x4*)(rowp + bj * HALF) = w; } }
    }
};
struct EpiSoftmax {
    static constexpr bool PERM = true;
    bf16* P; const float* ssq;
    __device__ __forceinline__ void operator()(f32x4 (&acc)[2][2][4][2], const Unit& u, int wr, int wc, int fr, int fq, LAS unsigned char* xl, int, int) const {
        const int rowt = u.pm * BM + wr * 64 + fr, col0 = u.pn * BM + wc * 32 + 8 * fq;
        LAS f32x2* X = (LAS f32x2*)xl;
        float ml[2][4], rs[2][4];
        rstd8(ssq, rowt, fq, rs, 1.0f);
#pragma unroll
        for (int ai = 0; ai < 2; ++ai)
#pragma unroll
            for (int m = 0; m < 4; ++m) {
                const float r = rs[ai][m];
                float mx = -3.0e38f;
#pragma unroll
                for (int bj = 0; bj < 2; ++bj)
#pragma unroll
                    for (int n = 0; n < 2; ++n) { f32x4 v = acc[ai][bj][m][n] * r; acc[ai][bj][m][n] = v; mx = fmaxf(fmaxf(fmaxf(v[0], v[1]), fmaxf(v[2], v[3])), mx); }
                mx = fmaxf(mx, __shfl_xor(mx, 16)); mx = fmaxf(mx, __shfl_xor(mx, 32));
                float l = 0.f;
#pragma unroll
                for (int bj = 0; bj < 2; ++bj)
#pragma unroll
                    for (int n = 0; n < 2; ++n) { f32x4 v = acc[ai][bj][m][n]; v[0] = __builtin_amdgcn_exp2f(v[0] - mx); v[1] = __builtin_amdgcn_exp2f(v[1] - mx); v[2] = __builtin_amdgcn_exp2f(v[2] - mx); v[3] = __builtin_amdgcn_exp2f(v[3] - mx);
                        acc[ai][bj][m][n] = v; l += (v[0] + v[1]) + (v[2] + v[3]); }
                l += __shfl_xor(l, 16); l += __shfl_xor(l, 32);
                ml[ai][m] = mx;
                if (fq == 0) X[(ai * HALF + wr * 64 + m * 16 + fr) * 4 + wc] = (f32x2){mx, l};
            }
        asm volatile("s_waitcnt lgkmcnt(0)" ::: "memory"); __builtin_amdgcn_s_barrier(); asm volatile("" ::: "memory");
#pragma unroll
        for (int ai = 0; ai < 2; ++ai)
#pragma unroll
            for (int m = 0; m < 4; ++m) {
                const LAS f32x2* xr = X + (ai * HALF + wr * 64 + m * 16 + fr) * 4;
                const f32x2 a = xr[0], b = xr[1], c = xr[2], d = xr[3];
                const float M = fmaxf(fmaxf(a.x, b.x), fmaxf(c.x, d.x));
                const float L = (a.y * __builtin_amdgcn_exp2f(a.x - M) + b.y * __builtin_amdgcn_exp2f(b.x - M)) + (c.y * __builtin_amdgcn_exp2f(c.x - M) + d.y * __builtin_amdgcn_exp2f(d.x - M));
                const float f = __builtin_amdgcn_exp2f(ml[ai][m] - M) / L;
                bf16* rowp = P + (size_t)(rowt + ai * HALF + m * 16) * DM + col0;
#pragma unroll
                for (int bj = 0; bj < 2; ++bj) { const f32x4 v0 = acc[ai][bj][m][0] * f, v1 = acc[ai][bj][m][1] * f;
                    u32x4 w; w.x = cvt_pk_bf16(v0[0], v0[1]); w.y = cvt_pk_bf16(v0[2], v0[3]); w.z = cvt_pk_bf16(v1[0], v1[1]); w.w = cvt_pk_bf16(v1[2], v1[3]);
                    *(GAS u32x4*)(rowp + bj * HALF) = w; }
            }
    }
};
struct EpiResidual {
    static constexpr bool PERM = false;
    const float* xold; float* xnew; bf16* xb; const float* bias; float* ssq;
    __device__ __forceinline__ void operator()(f32x4 (&acc)[2][2][4][2], const Unit& u, int wr, int wc, int fr, int fq, LAS unsigned char*, int, int) const {
        const int row0 = u.pm * BM + wr * 64 + fr, col0 = u.pn * BM + wc * 32 + 4 * fq;
        f32x4 bv[2][2];
#pragma unroll
        for (int bj = 0; bj < 2; ++bj)
#pragma unroll
            for (int n = 0; n < 2; ++n) bv[bj][n] = *(const GAS f32x4*)(bias + col0 + bj * HALF + n * 16);
#pragma unroll
        for (int ai = 0; ai < 2; ++ai)
#pragma unroll
            for (int m = 0; m < 4; ++m) { int row = row0 + ai * HALF + m * 16; asm volatile("" : "+v"(row)); const size_t off = (size_t)row * DM + col0; float sq = 0.f;
#pragma unroll
                for (int bj = 0; bj < 2; ++bj)
#pragma unroll
                    for (int n = 0; n < 2; ++n) { const f32x4 xo = *(const GAS f32x4*)(xold + off + bj * HALF + n * 16); const f32x4 v = (acc[ai][bj][m][n] + bv[bj][n]) + xo;
                        *(GAS f32x4*)(xnew + off + bj * HALF + n * 16) = v; sq += (v[0] * v[0] + v[1] * v[1]) + (v[2] * v[2] + v[3] * v[3]);
                        u32x2 w; w.x = cvt_pk_bf16(v[0], v[1]); w.y = cvt_pk_bf16(v[2], v[3]); *(GAS u32x2*)(xb + off + bj * HALF + n * 16) = w; }
                sq += __shfl_xor(sq, 16); sq += __shfl_xor(sq, 32);
                if (fq == 0) *(GAS float*)(ssq + (size_t)row * 16 + u.pn * 4 + wc) = sq;
                asm volatile("" ::: "memory"); }
    }
};

template <class Epi, class Sched>
__device__ __forceinline__ void gemm_phase(LAS unsigned char* lds, LAS unsigned char* xl, const Gemm g, const Sched& S, const Epi& E, const int tid) {
    const int wid = __builtin_amdgcn_readfirstlane(tid >> 6), lane = tid & 63, wr = wid >> 2, wc = wid & 3, fr = lane & 15, fq = lane >> 4;
    const int K = g.K, nt = K / BK;
    unsigned voffA[2], voffB[2];
#pragma unroll
    for (int i = 0; i < 2; ++i) { int R, C; stage_rc(tid * 16 + i * 8192, R, C); const int Rb = Epi::PERM ? ((R & ~31) + perm32(R & 31)) : R;
        voffA[i] = (unsigned)(R * g.lda + C) * 2u; voffB[i] = (unsigned)(Rb * g.ldb + C) * 2u; }
    const size_t kstep = (size_t)(BK * 2);
    const size_t hstepA = (size_t)HALF * g.lda * 2, hstepB = (size_t)HALF * g.ldb * 2;
    const unsigned ldsw = (unsigned)wid * 1024u;
    const int aoff = lds_byte(wr * 64 + fr, fq * 8), boff = lds_byte(wc * 32 + fr, fq * 8);
#define PG8_SA(b, h) (((b) * 2 + (h)) * HTB)
#define PG8_SB(b, h) ((4 + (b) * 2 + (h)) * HTB)
#define PG8_STAGE(bufoff, gbase, voff) do { _Pragma("unroll") for (int _i = 0; _i < 2; ++_i) \
        __builtin_amdgcn_global_load_lds((const unsigned*)((const char*)(gbase) + (voff)[_i]), (LAS unsigned*)(lds + (bufoff) + ldsw + _i * 8192), 16, 0, 0); } while (0)
#define PG8_LDA(dst, b, h) do { _Pragma("unroll") for (int m = 0; m < 4; ++m) _Pragma("unroll") for (int k = 0; k < 2; ++k) dst[m][k] = *(const LAS bf16x8*)(lds + PG8_SA(b, h) + aoff + m * 2048 + k * 1024); } while (0)
#define PG8_LDB(dst, b, h) do { _Pragma("unroll") for (int n = 0; n < 2; ++n) _Pragma("unroll") for (int k = 0; k < 2; ++k) dst[n][k] = *(const LAS bf16x8*)(lds + PG8_SB(b, h) + boff + n * 2048 + k * 1024); } while (0)
#define PG8_MMA(ai, bj, At, Bt) do { __builtin_amdgcn_s_setprio(1); _Pragma("unroll") for (int m = 0; m < 4; ++m) _Pragma("unroll") for (int n = 0; n < 2; ++n) _Pragma("unroll") for (int k = 0; k < 2; ++k) \
        acc[ai][bj][m][n] = __builtin_amdgcn_mfma_f32_16x16x32_bf16(Bt[n][k], At[m][k], acc[ai][bj][m][n], 0, 0, 0); __builtin_amdgcn_s_setprio(0); } while (0)
#define PG8_WAIT_V(n) asm volatile("s_waitcnt vmcnt(" #n ")" ::: "memory")
#define PG8_WAIT_L(n) asm volatile("s_waitcnt lgkmcnt(" #n ")" ::: "memory")
#define PG8_BAR __builtin_amdgcn_s_barrier()
#define PG8_SCHED __builtin_amdgcn_sched_barrier(0)
    Unit cur, nxt; int ui = 0;
    if (!S.next(0, cur)) return;
    f32x4 acc[2][2][4][2];
#pragma unroll
    for (int a = 0; a < 2; ++a)
#pragma unroll
        for (int b = 0; b < 2; ++b)
#pragma unroll
            for (int m = 0; m < 4; ++m)
#pragma unroll
                for (int n = 0; n < 2; ++n) acc[a][b][m][n] = (f32x4){0.f, 0.f, 0.f, 0.f};
    bf16x8 At[4][2], B0[2][2], B1[2][2];
    const char* cA = (const char*)(g.A + g.ma.off(cur)); const char* cB = (const char*)(g.Bt + g.mb.off(cur));
    PG8_STAGE(PG8_SB(0, 0), cB, voffB); PG8_STAGE(PG8_SB(0, 1), cB + hstepB, voffB); PG8_STAGE(PG8_SA(0, 0), cA, voffA); PG8_STAGE(PG8_SA(0, 1), cA + hstepA, voffA);
    if (wr == 1) PG8_BAR;
    PG8_WAIT_V(2); PG8_BAR;
    PG8_STAGE(PG8_SB(1, 0), cB + kstep, voffB); PG8_STAGE(PG8_SA(1, 0), cA + kstep, voffA); PG8_STAGE(PG8_SB(1, 1), cB + hstepB + kstep, voffB);
    PG8_WAIT_V(6); PG8_BAR;
    for (;;) {
        const bool has_next = S.next(ui + 1, nxt);
        const char* nA = has_next ? (const char*)(g.A + g.ma.off(nxt)) : cA; const char* nB = has_next ? (const char*)(g.Bt + g.mb.off(nxt)) : cB;
        for (int t = 0; t < nt; t += 2) {
            const bool last = (t == nt - 2);
            const char* a1 = cA + (size_t)(t + 1) * kstep;
            const char* a2 = last ? nA : cA + (size_t)(t + 2) * kstep; const char* b2 = last ? nB : cB + (size_t)(t + 2) * kstep;
            const char* a3 = a2 + kstep; const char* b3 = b2 + kstep;
            PG8_LDB(B0, 0, 0); PG8_LDB(B1, 0, 1); PG8_SCHED; PG8_LDA(At, 0, 0); PG8_STAGE(PG8_SA(1, 1), a1 + hstepA, voffA);
            PG8_WAIT_V(8); PG8_WAIT_L(0); PG8_BAR; PG8_MMA(0, 0, At, B0); PG8_MMA(0, 1, At, B1); PG8_BAR; PG8_SCHED;
            PG8_LDA(At, 0, 1); PG8_STAGE(PG8_SB(0, 0), b2, voffB); PG8_STAGE(PG8_SB(0, 1), b2 + hstepB, voffB); PG8_STAGE(PG8_SA(0, 0), a2, voffA);
            PG8_WAIT_V(8); PG8_WAIT_L(0); PG8_BAR; PG8_MMA(1, 0, At, B0); PG8_MMA(1, 1, At, B1); PG8_BAR; PG8_SCHED;
            PG8_LDB(B0, 1, 0); PG8_LDB(B1, 1, 1); PG8_SCHED; PG8_LDA(At, 1, 0); PG8_STAGE(PG8_SA(0, 1), a2 + hstepA, voffA);
            PG8_WAIT_V(8); PG8_WAIT_L(0); PG8_BAR; PG8_MMA(0, 0, At, B0); PG8_MMA(0, 1, At, B1); PG8_BAR; PG8_SCHED;
            PG8_LDA(At, 1, 1); PG8_STAGE(PG8_SB(1, 0), b3, voffB); PG8_STAGE(PG8_SB(1, 1), b3 + hstepB, voffB); PG8_STAGE(PG8_SA(1, 0), a3, voffA);
            PG8_WAIT_V(8); PG8_WAIT_L(0); PG8_BAR; PG8_MMA(1, 0, At, B0); PG8_MMA(1, 1, At, B1); PG8_BAR; PG8_SCHED;
        }
        if (wr == 0) PG8_BAR;
        { int fr_ = fr, fq_ = fq, lane_ = lane; asm volatile("" : "+v"(fr_), "+v"(fq_), "+v"(lane_));
          E(acc, cur, wr, wc, fr_, fq_, xl, wid, lane_); }
        if (!has_next) break;
#pragma unroll
        for (int a = 0; a < 2; ++a)
#pragma unroll
            for (int b = 0; b < 2; ++b)
#pragma unroll
                for (int m = 0; m < 4; ++m)
#pragma unroll
                    for (int n = 0; n < 2; ++n) acc[a][b][m][n] = (f32x4){0.f, 0.f, 0.f, 0.f};
        cur = nxt; cA = nA; cB = nB; ++ui;
        if (wr == 1) PG8_BAR;
    }
    PG8_WAIT_V(0);
    PG8_BAR;
#undef PG8_SA
#undef PG8_SB
#undef PG8_STAGE
#undef PG8_LDA
#undef PG8_LDB
#undef PG8_MMA
#undef PG8_WAIT_V
#undef PG8_WAIT_L
#undef PG8_BAR
#undef PG8_SCHED
}
}

typedef GAS unsigned gu32;
#define RLX_AGENT __ATOMIC_RELAXED, __HIP_MEMORY_SCOPE_AGENT
#define LDS_WAIT() asm volatile("s_waitcnt lgkmcnt(0)" ::: "memory")
#define VM_WAIT() asm volatile("s_waitcnt vmcnt(0)" ::: "memory")
__device__ __forceinline__ unsigned f2bf(float f) { unsigned u = __builtin_bit_cast(unsigned, f); return (u + 0x7fffu + ((u >> 16) & 1u)) >> 16; }
__device__ __forceinline__ unsigned pk2(float lo, float hi) { return f2bf(lo) | (f2bf(hi) << 16); }
__device__ __forceinline__ float bf2f(unsigned short h) { return __builtin_bit_cast(float, (unsigned)h << 16); }
__device__ __forceinline__ float bflo(unsigned w) { return __builtin_bit_cast(float, w << 16); }
__device__ __forceinline__ float bfhi(unsigned w) { return __builtin_bit_cast(float, w & 0xffff0000u); }
__device__ __forceinline__ float wave_sum(float v) {
#pragma unroll
    for (int o = 1; o < 64; o <<= 1) v += __shfl_xor(v, o);
    return v;
}
__device__ __forceinline__ float wave_max(float v) {
#pragma unroll
    for (int o = 1; o < 64; o <<= 1) v = fmaxf(v, __shfl_xor(v, o));
    return v;
}
__device__ __forceinline__ float gelu_tanh(float x) { const float u = 0.7978845608028654f * (x + 0.044715f * x * x * x); return x / (1.0f + __expf(-2.0f * u)); }
__device__ __forceinline__ float silu(float x) { return x / (1.0f + __expf(-x)); }

#define XB_TMO      128
#define XB_XCNT(j)  (256  + 64 * (j))
#define XB_XSUB(j)  (1280 + 64 * (j))
#define XB_XGEN(j)  (2304 + 64 * (j))
#define XB_TOP      3328
#define XB_TOPGEN   3392
#define XCD_BAR_WORDS 3456
#define XB_SPIN_CAP (1u << 18)
__device__ __forceinline__ unsigned xb_ld(unsigned* p)              { return __hip_atomic_load(p, __ATOMIC_RELAXED, __HIP_MEMORY_SCOPE_AGENT); }
__device__ __forceinline__ unsigned xb_add(unsigned* p, unsigned v) { return __hip_atomic_fetch_add(p, v, __ATOMIC_RELAXED, __HIP_MEMORY_SCOPE_AGENT); }
__device__ __forceinline__ unsigned xb_xcc_id() { return (unsigned)__builtin_amdgcn_s_getreg((3 << 11) | 20) & 0xFu; }
#define XB_SPIN(cond, bar) do { unsigned _sp = 0; while (cond) { __builtin_amdgcn_s_sleep(1); \
    if ((++_sp & 255u) == 0u) { if (xb_ld(&(bar)[XB_TMO])) break; if (_sp > XB_SPIN_CAP) { atomicAdd(&(bar)[XB_TMO], 1u); break; } } } } while (0)
struct XcdBarrier { unsigned* bar; unsigned x; volatile LAS unsigned* st; };
__device__ __forceinline__ XcdBarrier xcd_barrier_post(unsigned* bar, volatile LAS unsigned* st) {
    XcdBarrier b; b.bar = bar; b.x = xb_xcc_id(); b.st = st;
    if (threadIdx.x == 0) (void)xb_add(&bar[XB_XCNT(b.x)], 1u);
    return b;
}
__device__ __forceinline__ void xcd_barrier_complete(unsigned* bar, unsigned x, unsigned& nloc, unsigned& nx) {
    const unsigned G = gridDim.x * gridDim.y * gridDim.z;
    unsigned sum, cnt, mine, sp = 0u;
    for (;;) {
        sum = 0u; cnt = 0u; mine = 0u;
#pragma unroll
        for (unsigned j = 0; j < 16; ++j) { const unsigned c = xb_ld(&bar[XB_XCNT(j)]); sum += c; cnt += (c > 0u) ? 1u : 0u; mine = (j == x) ? c : mine; }
        if (sum == G) break;
        __builtin_amdgcn_s_sleep(1);
        if ((++sp & 255u) == 0u) { if (xb_ld(&bar[XB_TMO])) break; if (sp > XB_SPIN_CAP) { atomicAdd(&bar[XB_TMO], 1u); break; } }
    }
    nloc = mine > 0u ? mine : 1u; nx = cnt > 0u ? cnt : 1u;
}
__device__ __forceinline__ void xcd_barrier(const XcdBarrier& b) {
    asm volatile("s_waitcnt vmcnt(0)" ::: "memory");
    __syncthreads();
    if (threadIdx.x == 0) {
        unsigned* bar = b.bar;
        __builtin_amdgcn_s_waitcnt(0);
        unsigned nloc = b.st[0], nx = b.st[1];
        if (nloc == 0u) { xcd_barrier_complete(bar, b.x, nloc, nx); b.st[0] = nloc; b.st[1] = nx; }
        const unsigned old = xb_add(&bar[XB_XSUB(b.x)], 1u);
        const unsigned gen = old / nloc;
        if (old + 1u == (gen + 1u) * nloc) {
            __builtin_amdgcn_fence(__ATOMIC_RELEASE, "agent");
            asm volatile("s_waitcnt vmcnt(0)" ::: "memory");
            const unsigned og = xb_add(&bar[XB_TOP], 1u);
            const unsigned tg = og / nx;
            if (og + 1u == (tg + 1u) * nx) xb_add(&bar[XB_TOPGEN], 1u);
            else XB_SPIN(xb_ld(&bar[XB_TOPGEN]) == tg, bar);
            __builtin_amdgcn_fence(__ATOMIC_ACQUIRE, "agent");
            xb_add(&bar[XB_XGEN(b.x)], 1u);
            asm volatile("s_waitcnt vmcnt(0)" ::: "memory");
        } else {
            XB_SPIN(xb_ld(&bar[XB_XGEN(b.x)]) == gen, bar);
            __builtin_amdgcn_fence(__ATOMIC_ACQUIRE, "agent");
            asm volatile("s_waitcnt vmcnt(0)" ::: "memory");
        }
    }
    __syncthreads();
}

enum { I_X = 0, I_MEM, I_REL, I_MEMG, I_NMIXG, I_WIN, I_BIN, I_VG, I_WS, I_BS, I_PW, I_PB, I_PSC, I_WOUT, I_BOUT, I_NMEMG, I_WQ, I_WKV, I_WO, I_BO, I_NFFNG, I_WUP, I_BUP, I_CW, I_CB, I_WDOWN, I_BDOWN, I_FNG, N_IN };
struct Args { const float* in[N_IN]; float* out; unsigned char* ws; int ph_lo, ph_hi; };
constexpr int PH_PRO = 0, PH_KV = 1, PH_QV = 2, PH_L0 = 3, PH_PER_LAYER = 14, PH_FINAL = PH_L0 + 2 * PH_PER_LAYER, N_PHASES = PH_FINAL + 1;

struct Ctx {
    LAS unsigned char* lds; int tid, lane, wave, G, bid;
    const float* const* in; float* out; unsigned char* ws;
    __device__ __forceinline__ bf16* wl(int l, size_t off) const { return (bf16*)(ws + WS_W + (size_t)l * WL_STRIDE + off); }
};

__device__ __forceinline__ void tr_item(const float* W, int ldw, const float* gain, bf16* WT, int K, int k0, int n0, int drow0, LAS float* scr, int lane) {
#pragma unroll 8
    for (int i = 0; i < 32; ++i) { const int kk = 2 * i + (lane >> 5); float v = W[(size_t)(k0 + kk) * ldw + n0 + (lane & 31)]; if (gain) v *= gain[k0 + kk]; scr[kk * 33 + (lane & 31)] = v; }
    LDS_WAIT(); asm volatile("" ::: "memory");
    const int c = lane & 7;
#pragma unroll
    for (int j = 0; j < 4; ++j) { const int n = (lane >> 3) + 8 * j; const LAS float* s = scr + (8 * c) * 33 + n;
        u32x4 o; o.x = pk2(s[0 * 33], s[1 * 33]); o.y = pk2(s[2 * 33], s[3 * 33]); o.z = pk2(s[4 * 33], s[5 * 33]); o.w = pk2(s[6 * 33], s[7 * 33]);
        *(u32x4*)(WT + (size_t)(drow0 + n) * K + k0 + 8 * c) = o; }
    LDS_WAIT(); asm volatile("" ::: "memory");
}
__device__ __forceinline__ void phase_prologue(const Ctx& C) {
    LAS float* scr = (LAS float*)(C.lds + C.wave * 16384);
    const int gw = C.bid * 8 + C.wave, NGW = C.G * 8, lane = C.lane;
    constexpr int I_IN = 16 * 68, I_OUT = 12 * 32, I_KV = 16 * 64, I_O = 16 * 32, I_UP = 16 * 176, I_DN = 44 * 32, I_L = I_IN + I_OUT + I_KV + I_O + I_UP + I_DN;
    for (int it = gw; it < 2 * I_L; it += NGW) {
        const int l = it / I_L; int r = it % I_L;
        if (r < I_IN) { const int kb = r / 68, nb = r % 68; tr_item(C.in[I_WIN] + (size_t)l * DM * INW, INW, C.in[I_NMIXG] + l * DM, C.wl(l, WL_WIN), DM, kb * 64, nb * 32, nb * 32, scr, lane); continue; } r -= I_IN;
        if (r < I_OUT) { const int kb = r / 32, nb = r % 32; tr_item(C.in[I_WOUT] + (size_t)l * OUTW * DM, DM, nullptr, C.wl(l, WL_WOUT), OUTW, kb * 64, nb * 32, nb * 32, scr, lane); continue; } r -= I_OUT;
        if (r < I_KV) { const int kb = r / 64, nb = r % 64; tr_item(C.in[I_WKV] + (size_t)l * DM * 2048, 2048, nullptr, (bf16*)(C.ws + WS_WKVT) + (size_t)l * 2048 * DM, DM, kb * 64, nb * 32, nb * 32, scr, lane); continue; } r -= I_KV;
        if (r < I_O) { const int kb = r / 32, nb = r % 32; tr_item(C.in[I_WO] + (size_t)l * DM * DM, DM, nullptr, (bf16*)(C.ws + WS_WOT) + (size_t)l * DM * DM, DM, kb * 64, nb * 32, nb * 32, scr, lane); continue; } r -= I_O;
        if (r < I_UP) { const int kb = r / 176, nb = r % 176; const int n0 = nb * 32; const int drow = n0 < DFF ? (n0 / 128) * 256 + (n0 % 128) : ((n0 - DFF) / 128) * 256 + 128 + ((n0 - DFF) % 128);
            tr_item(C.in[I_WUP] + (size_t)l * DM * DFF2, DFF2, C.in[I_NFFNG] + l * DM, C.wl(l, WL_WUP), DM, kb * 64, n0, drow, scr, lane); continue; } r -= I_UP;
        { const int kb = r / 32, nb = r % 32; tr_item(C.in[I_WDOWN] + (size_t)l * DFF * DM, DM, nullptr, C.wl(l, WL_WDOWN), DFF, kb * 64, nb * 32, nb * 32, scr, lane); }
    }
    for (int i = gw * 64 + lane; i < 2 * (INWP - INW) * DM / 8; i += NGW * 64) { const int l = i / ((INWP - INW) * DM / 8), j = i % ((INWP - INW) * DM / 8);
        *((u32x4*)(C.wl(l, WL_WIN) + (size_t)INW * DM) + j) = (u32x4){0u, 0u, 0u, 0u}; }
    for (int r = gw; r < 2 * DM; r += NGW) { const int l = r / DM, k = r % DM; const float gk = C.in[I_NMEMG][l * DM + k];
        const f32x4* src = (const f32x4*)(C.in[I_WQ] + (size_t)l * DM * DM + (size_t)k * DM); u32x2* dst = (u32x2*)((bf16*)(C.ws + WS_WQ) + (size_t)l * DM * DM + (size_t)k * DM);
#pragma unroll
        for (int j = 0; j < 4; ++j) { const f32x4 v = src[lane + 64 * j] * gk; u32x2 w; w.x = pk2(v[0], v[1]); w.y = pk2(v[2], v[3]); dst[lane + 64 * j] = w; } }
    for (int r = gw; r < TOK; r += NGW) { const f32x4* src = (const f32x4*)(C.in[I_X] + (size_t)r * DM); u32x2* dst = (u32x2*)((bf16*)(C.ws + WS_XB) + (size_t)r * DM); float s = 0.f;
#pragma unroll
        for (int j = 0; j < 4; ++j) { const f32x4 v = src[lane + 64 * j]; s += (v[0] * v[0] + v[1] * v[1]) + (v[2] * v[2] + v[3] * v[3]); u32x2 w; w.x = pk2(v[0], v[1]); w.y = pk2(v[2], v[3]); dst[lane + 64 * j] = w; }
        s = wave_sum(s); if (lane < 16) ((float*)(C.ws + WS_SSQ))[(size_t)r * 16 + lane] = lane == 0 ? s : 0.f; }
    for (int r = gw; r < MEMR; r += NGW) { const f32x4* src = (const f32x4*)(C.in[I_MEM] + (size_t)r * DM); const f32x4* gg = (const f32x4*)C.in[I_MEMG]; u32x2* dst = (u32x2*)((bf16*)(C.ws + WS_MEMN) + (size_t)r * DM);
        f32x4 v[4]; float s = 0.f;
#pragma unroll
        for (int j = 0; j < 4; ++j) { v[j] = src[lane + 64 * j]; s += (v[j][0] * v[j][0] + v[j][1] * v[j][1]) + (v[j][2] * v[j][2] + v[j][3] * v[j][3]); }
        const float rs = 1.0f / sqrtf(wave_sum(s) * (1.0f / DM) + EPS);
#pragma unroll
        for (int j = 0; j < 4; ++j) { const f32x4 o = v[j] * rs * gg[lane + 64 * j]; u32x2 w; w.x = pk2(o[0], o[1]); w.y = pk2(o[2], o[3]); dst[lane + 64 * j] = w; } }
    float* tab = (float*)(C.ws + WS_TAB);
    for (int i = C.bid * 512 + C.tid; i < 2 * INWP; i += C.G * 512) { const int l = i / INWP, c = i % INWP; tab[i] = c < INW ? C.in[I_BIN][l * INW + c] : 0.f; }
    for (int i = C.bid * 512 + C.tid; i < 2 * DFF2; i += C.G * 512) { const int l = i / DFF2, c = i % DFF2; const int t = c >> 8, w = c & 255; const int src = w < 128 ? t * 128 + w : DFF + t * 128 + (w - 128);
        tab[2 * INWP + i] = C.in[I_BUP][l * DFF2 + src]; }
}

__device__ __forceinline__ int t5_bucket(int rel) {
    const int n = rel < 0 ? -rel : rel; int b = rel > 0 ? 16 : 0;
    if (n < 8) return b + n;
    return b + 8 + (n >= 15) + (n >= 27) + (n >= 50) + (n >= 91) + (n >= 166) + (n >= 305) + (n >= 559);
}
__device__ __forceinline__ void phase_mixer(const Ctx& C, int l) {
    const bf16* z = (const bf16*)(C.ws + WS_Z); bf16* y = (bf16*)(C.ws + WS_Y);
    const int lane = C.lane, wave = C.wave, tid = C.tid;
    {
        LAS float* vn = (LAS float*)C.lds;
        const float* ws_ = C.in[I_WS] + (size_t)l * 6 * 128 * 128; const float* bs_ = C.in[I_BS] + l * 6 * 128; const float* vg = C.in[I_VG] + l * 6 * 64;
        for (int uu = C.bid; uu < NBATCH * 32 * 6; uu += C.G) {
            const int h = uu % 6, n = (uu / 6) % 32, b = uu / 192; const size_t r0 = (size_t)b * SEQ + n * 128;
            for (int i = 0; i < 16; ++i) { const int q = wave * 16 + i; const float val = gelu_tanh(bf2f(z[(r0 + q) * INWP + 384 + h * 64 + lane]));
                const float ss = wave_sum(val * val); vn[q * 64 + lane] = val * (1.0f / sqrtf(ss * (1.0f / 64) + EPS)) * vg[h * 64 + lane]; }
            __syncthreads();
            float vcol[128];
#pragma unroll
            for (int q = 0; q < 128; ++q) vcol[q] = vn[q * 64 + lane];
            for (int i = 0; i < 16; ++i) { const int p = wave * 16 + i; const float* wrow = ws_ + ((size_t)h * 128 + p) * 128; float a = 0.f;
#pragma unroll
                for (int q = 0; q < 128; ++q) a += wrow[q] * vcol[q];
                const float u = gelu_tanh(bf2f(z[(r0 + p) * INWP + h * 64 + lane]));
                y[(r0 + p) * OUTW + h * 64 + lane] = (bf16)f2bf(u * (a + bs_[h * 128 + p])); }
            __syncthreads();
        }
    }
    {
        LAS float* pl = (LAS float*)(C.lds + 32768);
        const float* pw = C.in[I_PW] + (size_t)l * 4 * 64 * 64; const float* pb = C.in[I_PB] + l * 256; const float* psc = C.in[I_PSC] + l * 256;
        for (int uu = C.bid; uu < TOK / 32; uu += C.G) {
            const int r0 = uu * 32; const int c = tid & 255, g = c >> 6, hw = 1 << g;
            for (int i = 0; i < 16; ++i) { const int t = (tid >> 8) * 16 + i; const int row = r0 + t, pos = row & (SEQ - 1), base = row - pos;
                const int lo = pos - hw < 0 ? 0 : pos - hw, hi = pos + hw > SEQ ? SEQ : pos + hw; float s = 0.f;
                for (int p = lo; p < hi; ++p) s += bf2f(z[(size_t)(base + p) * INWP + 768 + c]);
                pl[t * 256 + c] = s / (float)(hi - lo) - bf2f(z[(size_t)row * INWP + 768 + c]); }
            __syncthreads();
            const int f = c & 63; float a16[16];
#pragma unroll
            for (int i = 0; i < 16; ++i) a16[i] = 0.f;
            const float* wp = pw + (g * 64) * 64 + f; const LAS float* plr = pl + (tid >> 8) * 16 * 256 + g * 64;
#pragma unroll 2
            for (int e = 0; e < 64; ++e) { const float w = wp[e * 64];
#pragma unroll
                for (int i = 0; i < 16; ++i) a16[i] += plr[i * 256 + e] * w; }
#pragma unroll
            for (int i = 0; i < 16; ++i) { const int t = (tid >> 8) * 16 + i; y[(size_t)(r0 + t) * OUTW + 384 + c] = (bf16)f2bf((a16[i] + pb[c]) * psc[c]); }
            __syncthreads();
        }
    }
    {
        LAS float* tab = (LAS float*)(C.lds + 73728);
        LAS float* qs = (LAS float*)(C.lds + 65536) + wave * 256;
        LAS float* ps = qs + 64;
        for (int i = tid; i < 3 * 2 * 129; i += 512) { const int j = i % 129 - 64, gh = i / 129, g = gh >> 1; const int d = g == 0 ? 1 : (g == 1 ? 4 : 16);
            tab[i] = C.in[I_REL][t5_bucket(j * d) * 6 + gh]; }
        __syncthreads();
        for (int uu = C.bid; uu < TOK / 4; uu += C.G) {
            const int row = uu * 4 + (wave >> 1), h = wave & 1, pos = row & (SEQ - 1), base = row - pos;
            float m = -3.0e38f, lsum = 0.f, acc = 0.f;
            for (int g = 0; g < 3; ++g) {
                const int d = g == 0 ? 1 : (g == 1 ? 4 : 16);
                qs[lane] = bf2f(z[(size_t)row * INWP + 1024 + g * 128 + h * 64 + lane]) * 0.125f;
                float lg[3];
#pragma unroll
                for (int rd = 0; rd < 3; ++rd) { const int jj = lane + 64 * rd, kp = pos + d * (jj - 64); const bool ok = jj <= 128 && kp >= 0 && kp < SEQ; float s = -1.0e30f;
                    if (ok) { const u32x4* kr = (const u32x4*)(z + (size_t)(base + kp) * INWP + 1408 + g * 128 + h * 64); s = 0.f;
#pragma unroll
                        for (int c8 = 0; c8 < 8; ++c8) { const u32x4 kv = kr[c8]; const LAS float* qq = qs + c8 * 8;
                            s += qq[0] * bflo(kv.x) + qq[1] * bfhi(kv.x) + qq[2] * bflo(kv.y) + qq[3] * bfhi(kv.y) + qq[4] * bflo(kv.z) + qq[5] * bfhi(kv.z) + qq[6] * bflo(kv.w) + qq[7] * bfhi(kv.w); }
                        s += tab[(g * 2 + h) * 129 + jj]; }
                    lg[rd] = s; }
                const float mg = wave_max(fmaxf(fmaxf(lg[0], lg[1]), lg[2])); const float mn = fmaxf(m, mg); const float sc = __expf(m - mn);
                acc *= sc; lsum *= sc; m = mn; float psum = 0.f;
#pragma unroll
                for (int rd = 0; rd < 3; ++rd) { const float p = lg[rd] > -1.0e29f ? __expf(lg[rd] - mn) : 0.f; ps[lane + 64 * rd] = p; psum += p; }
                lsum += wave_sum(psum);
                const bf16* vb = z + 1792 + g * 128 + h * 64 + lane;
                for (int jj = 0; jj <= 128; ++jj) { const float p = ps[jj]; int kp = pos + d * (jj - 64); kp = kp < 0 ? 0 : (kp >= SEQ ? SEQ - 1 : kp);
                    acc += p * bf2f(vb[(size_t)(base + kp) * INWP]); }
            }
            y[(size_t)row * OUTW + 640 + h * 64 + lane] = (bf16)f2bf(acc / lsum);
        }
        __syncthreads();
    }
}

__device__ __forceinline__ void phase_conv(const Ctx& C, int l, int qd) {
    const bf16* uq = (const bf16*)(C.ws + WS_UQ); bf16* gout = (bf16*)(C.ws + WS_G) + (size_t)qd * SEQ * DFF;
    const float* cw = C.in[I_CW] + (size_t)l * 3 * DFF2; const float* cb = C.in[I_CB] + (size_t)l * DFF2;
    const int NI = SEQ * (DFF / 8);
    for (int i = C.bid * 512 + C.tid; i < NI; i += C.G * 512) {
        const int row = i / (DFF / 8), c8 = (i % (DFF / 8)) * 8; const int t = c8 >> 7, w = c8 & 127;
        const bf16* pg = uq + (size_t)row * DFF2 + t * 256 + w; const bf16* pv = pg + 128;
        const u32x4 zero = (u32x4){0u, 0u, 0u, 0u};
        const u32x4 g0 = row > 0 ? *(const u32x4*)(pg - DFF2) : zero, g1 = *(const u32x4*)pg, g2 = row < SEQ - 1 ? *(const u32x4*)(pg + DFF2) : zero;
        const u32x4 v0 = row > 0 ? *(const u32x4*)(pv - DFF2) : zero, v1 = *(const u32x4*)pv, v2 = row < SEQ - 1 ? *(const u32x4*)(pv + DFF2) : zero;
        float o[8];
#pragma unroll
        for (int e = 0; e < 8; ++e) { const int cg = c8 + e, cv = DFF + c8 + e;
            const unsigned a0 = g0[e >> 1], a1 = g1[e >> 1], a2 = g2[e >> 1], b0 = v0[e >> 1], b1 = v1[e >> 1], b2 = v2[e >> 1];
            const float ga = (e & 1) ? bfhi(a0) : bflo(a0), gb = (e & 1) ? bfhi(a1) : bflo(a1), gc = (e & 1) ? bfhi(a2) : bflo(a2);
            const float va = (e & 1) ? bfhi(b0) : bflo(b0), vb = (e & 1) ? bfhi(b1) : bflo(b1), vc = (e & 1) ? bfhi(b2) : bflo(b2);
            const float gt = cw[cg] * ga + cw[DFF2 + cg] * gb + cw[2 * DFF2 + cg] * gc + cb[cg];
            const float vl = cw[cv] * va + cw[DFF2 + cv] * vb + cw[2 * DFF2 + cv] * vc + cb[cv];
            o[e] = silu(gt) * vl; }
        u32x4 w4; w4.x = pk2(o[0], o[1]); w4.y = pk2(o[2], o[3]); w4.z = pk2(o[4], o[5]); w4.w = pk2(o[6], o[7]);
        *(u32x4*)(gout + (size_t)row * DFF + c8) = w4;
    }
}

__device__ __forceinline__ void phase_final(const Ctx& C) {
    const int gw = C.bid * 8 + C.wave, NGW = C.G * 8, lane = C.lane; const f32x4* gg = (const f32x4*)C.in[I_FNG];
    for (int r = gw; r < TOK; r += NGW) { f32x4* xr = (f32x4*)(C.out + (size_t)r * DM); f32x4 v[4]; float s = 0.f;
#pragma unroll
        for (int j = 0; j < 4; ++j) { v[j] = xr[lane + 64 * j]; s += (v[j][0] * v[j][0] + v[j][1] * v[j][1]) + (v[j][2] * v[j][2] + v[j][3] * v[j][3]); }
        const float rs = 1.0f / sqrtf(wave_sum(s) * (1.0f / DM) + EPS);
#pragma unroll
        for (int j = 0; j < 4; ++j) xr[lane + 64 * j] = v[j] * rs * gg[lane + 64 * j]; }
}

__global__ void __launch_bounds__(512, 2) enc_fwd(Args args) {
    extern __shared__ __attribute__((aligned(16))) unsigned char lds_raw[];
    LAS unsigned char* const lds0 = (LAS unsigned char*)lds_raw;
    volatile LAS unsigned* MISC = (volatile LAS unsigned*)(lds0 + MISC_OFF);
    for (int u = threadIdx.x; u < (LDS_BYTES - LDSCTL_OFF) / 4; u += 512) ((LAS unsigned*)(lds0 + LDSCTL_OFF))[u] = 0u;
    __syncthreads();
    XcdBarrier bar; bar.bar = (unsigned*)(args.ws + WS_CTL) + 4096; bar.x = 0; bar.st = nullptr;
    const int lo = args.ph_lo, hi = args.ph_hi;
    const int wave_s = __builtin_amdgcn_readfirstlane(threadIdx.x >> 6);
    if (hi - lo > 1) bar = xcd_barrier_post((unsigned*)(args.ws + WS_CTL) + 4096, MISC + 8);

    for (int ph = lo; ph < hi; ++ph) {
        if (ph > lo) xcd_barrier(bar);
        unsigned zero_ = 0u; asm volatile("" : "+v"(zero_));
        int tid_ = wave_s * 64 + (int)__builtin_amdgcn_mbcnt_hi(~0u, __builtin_amdgcn_mbcnt_lo(~0u, zero_));
        unsigned char* ws_ = args.ws; asm volatile("" : "+s"(ws_));
        float* out_ = args.out; asm volatile("" : "+s"(out_));
        Ctx C; C.lds = lds0; C.tid = tid_; C.lane = tid_ & 63; C.wave = wave_s; C.G = gridDim.x; C.bid = blockIdx.x;
        C.in = args.in; C.out = out_; C.ws = ws_;
        LAS unsigned char* ring = C.lds; LAS unsigned char* xl = C.lds + XL_OFF;
        const int G = C.G, bid = C.bid;
        float* ssq = (float*)(C.ws + WS_SSQ); const float* tab = (const float*)(C.ws + WS_TAB);
        bf16* xb = (bf16*)(C.ws + WS_XB);
        if (ph == PH_PRO) { phase_prologue(C); continue; }
        if (ph == PH_FINAL) { phase_final(C); continue; }
        int kind = 0; pg8::Gemm g{}; pg8::StaticOrder S{}; pg8::EpiRowBf16 E0{}; pg8::EpiSoftmax E1{}; pg8::EpiResidual E2{};
        int njobs = 1;
        const int lph = (ph - PH_L0) % PH_PER_LAYER, l = ph >= PH_L0 ? (ph - PH_L0) / PH_PER_LAYER : 0;
        if (ph == PH_KV) njobs = 2; else if (ph == PH_QV) njobs = 4;
        else if (lph == 1) { phase_mixer(C, l); continue; }
        else if (lph >= 5 && lph <= 12 && ((lph - 5) & 1)) { phase_conv(C, l, (lph - 5) >> 1); continue; }
        for (int job = 0; job < njobs; ++job) {
            if (ph == PH_KV) {
                const int ll = job;
                g.A = (const bf16*)(C.ws + WS_MEMN); g.Bt = (const bf16*)(C.ws + WS_WKVT) + (size_t)ll * 2048 * DM; g.K = DM; g.lda = DM; g.ldb = DM; g.ma = pg8::map_rows(DM); g.mb = pg8::map_cols(DM);
                S.init(4, 8, G, (bid + G - 32 * job) % G);
                kind = 0; E0 = pg8::EpiRowBf16{(bf16*)(C.ws + WS_KV) + (size_t)ll * MEMR * 2048, 2048, nullptr, nullptr, 0, 1.0f};
            } else if (ph == PH_QV) {
                const int ll = job >> 1; const bf16* KV = (const bf16*)(C.ws + WS_KV) + (size_t)ll * MEMR * 2048;
                if ((job & 1) == 0) {
                    g.A = KV; g.lda = 2048; g.ma = pg8::OpMap{2, 3, 0, 0, 256 * 2048, 256, 0, 0};
                    g.Bt = (const bf16*)(C.ws + WS_WQ) + (size_t)ll * DM * DM; g.ldb = DM; g.mb = pg8::OpMap{0, 3, 0, 0, 0, 256, 256 * DM, 0}; g.K = 256;
                    S.init(16, 4, G, (bid + G - 64 * job) % G);
                    kind = 0; E0 = pg8::EpiRowBf16{C.wl(ll, WL_QKT), DM, nullptr, nullptr, 0, 0.0625f * LOG2E};
                } else {
                    g.A = (const bf16*)(C.ws + WS_WOT) + (size_t)ll * DM * DM; g.lda = DM; g.ma = pg8::OpMap{0, 0, 0, 3, 256 * DM, 0, 0, 256};
                    g.Bt = KV + 1024; g.ldb = 2048; g.mb = pg8::OpMap{0, 0, 2, 3, 0, 0, 256 * 2048, 256}; g.K = 256;
                    S.init(4, 16, G, (bid + G - 64 * job) % G);
                    kind = 0; E0 = pg8::EpiRowBf16{C.wl(ll, WL_VOT), 4096, nullptr, nullptr, 0, 1.0f};
                }
            } else if (lph == 0) {
                g.A = xb; g.Bt = C.wl(l, WL_WIN); g.K = DM; g.lda = DM; g.ldb = DM; g.ma = pg8::map_rows(DM); g.mb = pg8::map_cols(DM);
                S.init(64, 9, G, bid); kind = 0; E0 = pg8::EpiRowBf16{(bf16*)(C.ws + WS_Z), INWP, tab + l * INWP, ssq, 0, 1.0f};
            } else if (lph == 2) {
                g.A = (const bf16*)(C.ws + WS_Y); g.Bt = C.wl(l, WL_WOUT); g.K = OUTW; g.lda = OUTW; g.ldb = OUTW; g.ma = pg8::map_rows(OUTW); g.mb = pg8::map_cols(OUTW);
                S.init(64, 4, G, bid); kind = 2; E2 = pg8::EpiResidual{l == 0 ? C.in[I_X] : C.out, C.out, xb, C.in[I_BOUT] + l * DM, ssq};
            } else if (lph == 3) {
                g.A = xb; g.Bt = C.wl(l, WL_QKT); g.K = DM; g.lda = DM; g.ldb = DM; g.ma = pg8::map_rows(DM); g.mb = pg8::OpMap{4, 0, 0, 0, 1024 * 1024, 0, 256 * DM, 0};
                S.init(64, 4, G, bid); kind = 1; E1 = pg8::EpiSoftmax{(bf16*)(C.ws + WS_P), ssq};
            } else if (lph == 4) {
                g.A = (const bf16*)(C.ws + WS_P); g.Bt = C.wl(l, WL_VOT); g.K = DM; g.lda = DM; g.ldb = 4096; g.ma = pg8::map_rows(DM); g.mb = pg8::OpMap{4, 0, 0, 0, 1024, 0, 256 * 4096, 0};
                S.init(64, 4, G, bid); kind = 2; E2 = pg8::EpiResidual{C.out, C.out, xb, C.in[I_BO] + l * DM, ssq};
            } else if (lph >= 5 && lph <= 12) {
                const int qd = (lph - 5) >> 1; g.A = xb + (size_t)qd * SEQ * DM; g.Bt = C.wl(l, WL_WUP); g.K = DM; g.lda = DM; g.ldb = DM; g.ma = pg8::map_rows(DM); g.mb = pg8::map_cols(DM);
                S.init(16, 22, G, bid); kind = 0; E0 = pg8::EpiRowBf16{(bf16*)(C.ws + WS_UQ), DFF2, tab + 2 * INWP + l * DFF2, ssq, qd * SEQ, 1.0f};
            } else {
                g.A = (const bf16*)(C.ws + WS_G); g.Bt = C.wl(l, WL_WDOWN); g.K = DFF; g.lda = DFF; g.ldb = DFF; g.ma = pg8::map_rows(DFF); g.mb = pg8::map_cols(DFF);
                S.init(64, 4, G, bid); kind = 2; E2 = pg8::EpiResidual{C.out, C.out, xb, C.in[I_BDOWN] + l * DM, ssq};
            }
            if (kind == 0) pg8::gemm_phase<pg8::EpiRowBf16, pg8::StaticOrder>(ring, xl, g, S, E0, C.tid);
            else if (kind == 1) pg8::gemm_phase<pg8::EpiSoftmax, pg8::StaticOrder>(ring, xl, g, S, E1, C.tid);
            else pg8::gemm_phase<pg8::EpiResidual, pg8::StaticOrder>(ring, xl, g, S, E2, C.tid);
        }
    }
}

extern "C" void kernel_launch(void* const* d_in, const int* in_sizes, int n_in, void* d_out, int out_size, void* d_ws, size_t ws_size, hipStream_t stream) {
    static int grid = 0;
    if (grid == 0) {
        if (n_in != N_IN || in_sizes[0] != TOK * DM || out_size != TOK * DM || ws_size < 256 * MiB) { fprintf(stderr, "kernel_launch: unexpected shapes (n_in %d, in0 %d, out %d, ws %zu)\n", n_in, n_in > 0 ? in_sizes[0] : -1, out_size, ws_size); grid = -1; return; }
        int dev = 0, cus = 0, per_cu = 0;
        if (hipGetDevice(&dev) != hipSuccess || hipDeviceGetAttribute(&cus, hipDeviceAttributeMultiprocessorCount, dev) != hipSuccess) { grid = -1; return; }
        if (hipFuncSetAttribute((const void*)enc_fwd, hipFuncAttributeMaxDynamicSharedMemorySize, LDS_BYTES) != hipSuccess) { fprintf(stderr, "kernel_launch: hipFuncSetAttribute failed\n"); grid = -1; return; }
        if (hipOccupancyMaxActiveBlocksPerMultiprocessor(&per_cu, (const void*)enc_fwd, 512, LDS_BYTES) != hipSuccess || per_cu < 1) fprintf(stderr, "kernel_launch: occupancy query says %d\n", per_cu);
        (void)hipGetLastError();
        grid = cus;
    }
    if (grid < 0) return;
    if (hipMemsetAsync((char*)d_ws + WS_CTL, 0, CTL_ZERO_BYTES, stream) != hipSuccess) return;
    Args a{};
    for (int i = 0; i < N_IN; ++i) a.in[i] = (const float*)d_in[i];
    a.out = (float*)d_out; a.ws = (unsigned char*)d_ws;
#if MK_PER_PHASE
    for (int ph = 0; ph < N_PHASES; ++ph) { a.ph_lo = ph; a.ph_hi = ph + 1; hipLaunchKernelGGL(enc_fwd, dim3(grid), dim3(512), LDS_BYTES, stream, a); }
#else
    a.ph_lo = 0; a.ph_hi = N_PHASES; hipLaunchKernelGGL(enc_fwd, dim3(grid), dim3(512), LDS_BYTES, stream, a);
#endif
}
```

```cpp
#include <hip/hip_runtime.h>
#include <cstdio>
#include <cstdint>

#ifndef PROBE_KIND
#define PROBE_KIND 0
#endif
#ifndef MK_PER_PHASE
#define MK_PER_PHASE 0
#endif

#define LAS __attribute__((address_space(3)))
#define GAS __attribute__((address_space(1)))
typedef unsigned short bf16;
typedef short bf16x8 __attribute__((ext_vector_type(8)));
typedef float f32x4 __attribute__((ext_vector_type(4)));
typedef float f32x2 __attribute__((ext_vector_type(2)));
typedef unsigned u32x4 __attribute__((ext_vector_type(4)));
typedef unsigned u32x2 __attribute__((ext_vector_type(2)));

constexpr int NBATCH = 4, SEQ = 4096, DM = 1024, TOK = NBATCH * SEQ;
constexpr int INW = 2176, INWP = 2304, OUTW = 768, DFF = 2816, DFF2 = 5632, MEML = 256, MEMR = NBATCH * MEML;
constexpr float EPS = 1e-6f;
constexpr float LOG2E = 1.4426950408889634f;
constexpr float QSCALE = 0.125f * LOG2E;

constexpr size_t MiB = 1u << 20;
constexpr size_t WS_CTL = 0, CTL_ZERO_BYTES = 1 * MiB;
constexpr size_t WS_SSQ = 1 * MiB;
constexpr size_t WS_TAB = 2 * MiB;
constexpr size_t WS_W = 3 * MiB;
constexpr size_t WL_WIN = 0, WL_WOUT = 4608 * 1024, WL_WUP = WL_WOUT + 1536 * 1024, WL_WDOWN = WL_WUP + 11 * MiB, WL_QKT = WL_WDOWN + 5632 * 1024, WL_VOT = WL_QKT + 8 * MiB, WL_STRIDE = WL_VOT + 8 * MiB;
static_assert(WL_STRIDE == 38 * MiB + 512 * 1024, "weights per layer");
constexpr size_t WS_XB = 80 * MiB;
constexpr size_t WS_TR = 112 * MiB;
constexpr size_t WS_Z = WS_TR, WS_Y = WS_TR + 72 * MiB;
constexpr size_t WS_P = WS_TR;
constexpr size_t WS_G = WS_TR, WS_UQ = WS_TR + 88 * MiB;
constexpr size_t WS_OG = WS_TR + 96 * MiB, WS_LSE = WS_TR + 104 * MiB;
constexpr size_t WS_WQ = WS_TR + 96 * MiB, WS_WKVT = WS_WQ + 4 * MiB, WS_WOT = WS_WKVT + 8 * MiB, WS_MEMN = WS_WOT + 4 * MiB, WS_KV = WS_MEMN + 2 * MiB, WS_END = WS_KV + 8 * MiB;
static_assert(WS_END <= 256 * MiB && WS_W + 2 * WL_STRIDE <= WS_XB && WS_UQ + (size_t)SEQ * DFF2 * 2 <= 256 * MiB, "ws map");

constexpr int RING_BYTES = 131072, XL_OFF = 131072, LDSCTL_OFF = 139264, MISC_OFF = LDSCTL_OFF + 320, LDS_BYTES = 147456;

namespace pg8 {
constexpr int BM = 256, BK = 64, HALF = 128, HTB = HALF * BK * 2, STAGE_BYTES = 8 * HTB, NXCD = 8, WGM = 8;
__host__ __device__ __forceinline__ int lds_byte(int r, int c) { const int st = (r >> 4) * 2 + (c >> 5), rr = r & 15, cc = c & 31, ob = rr * 64 + cc * 2; return st * 1024 + (ob ^ (((ob >> 9) & 1) << 5)); }
__host__ __device__ __forceinline__ void stage_rc(int b, int& R, int& C) { const int st = b / 1024, sb = b % 1024, swz = sb ^ (((sb >> 9) & 1) << 5); R = (st >> 1) * 16 + swz / 64; C = (st & 1) * 32 + (swz % 64) / 2; }
__host__ __device__ __forceinline__ int perm32(int rho) { const int n = rho >> 4, i = rho & 15; return 8 * (i >> 2) + 4 * n + (i & 3); }

struct Unit { int pm, pn; };
struct OpMap { int sh_m, mk_m, sh_n, mk_n; int c_mhi, c_mlo, c_nhi, c_nlo;
    __device__ __forceinline__ long long off(const Unit& u) const { return (long long)((u.pm >> sh_m) * c_mhi + (u.pm & mk_m) * c_mlo + (u.pn >> sh_n) * c_nhi + (u.pn & mk_n) * c_nlo); } };
struct Gemm { const bf16* A; const bf16* Bt; int K, lda, ldb; OpMap ma, mb; };
__device__ __forceinline__ OpMap map_rows(int ld) { OpMap m{0, 0, 0, 0, 0, 0, 0, 0}; m.c_mhi = 256 * ld; return m; }
__device__ __forceinline__ OpMap map_cols(int ld) { OpMap m{0, 0, 0, 0, 0, 0, 0, 0}; m.c_nhi = 256 * ld; return m; }

struct StaticOrder {
    int nM, nN, nwg, G, c;
    __device__ void init(int nM_, int nN_, int G_, int c_) { nM = nM_; nN = nN_; nwg = nM * nN; G = G_; c = c_; }
    __device__ bool next(int i, Unit& u) const {
        const long L = (long)i * G + c; if (L >= nwg) return false;
        int wgid = (int)L; { const int q = nwg / NXCD, r = nwg % NXCD, xcd = wgid % NXCD, off = wgid / NXCD; wgid = (xcd < r ? xcd * (q + 1) : r * (q + 1) + (xcd - r) * q) + off; }
        const int nig = WGM * nN, gid = wgid / nig, fm = gid * WGM, gsz = (nM - fm) < WGM ? (nM - fm) : WGM;
        u.pm = fm + ((wgid % nig) % gsz); u.pn = (wgid % nig) / gsz; return true;
    }
};

__device__ __forceinline__ unsigned cvt_pk_bf16(float lo, float hi) { unsigned r; asm volatile("v_cvt_pk_bf16_f32 %0, %1, %2" : "=v"(r) : "v"(lo), "v"(hi)); return r; }

__device__ __forceinline__ void rstd8(const float* ssq, int row0  , int fq, float (&rs)[2][4], float mul) {
    f32x4 p[2][4];
#pragma unroll
    for (int ai = 0; ai < 2; ++ai)
#pragma unroll
        for (int m = 0; m < 4; ++m) p[ai][m] = *(const GAS f32x4*)(ssq + (size_t)(row0 + ai * HALF + m * 16) * 16 + fq * 4);
#pragma unroll
    for (int ai = 0; ai < 2; ++ai)
#pragma unroll
        for (int m = 0; m < 4; ++m) { float s = (p[ai][m][0] + p[ai][m][1]) + (p[ai][m][2] + p[ai][m][3]); s += __shfl_xor(s, 16); s += __shfl_xor(s, 32);
            rs[ai][m] = mul / sqrtf(s * (1.0f / DM) + EPS); }
}
struct EpiRowBf16 {
    static constexpr bool PERM = true;
    bf16* O; int ldc; const float* bias; const float* ssq; int ssq_row_off; float cscale;
    __device__ __forceinline__ void operator()(f32x4 (&acc)[2][2][4][2], const Unit& u, int wr, int wc, int fr, int fq, LAS unsigned char*, int, int) const {
        const int rowt = u.pm * BM + wr * 64 + fr, col0 = u.pn * BM + wc * 32 + 8 * fq;
        float rs[2][4];
        if (ssq) rstd8(ssq, ssq_row_off + rowt, fq, rs, cscale);
        else {
#pragma unroll
            for (int ai = 0; ai < 2; ++ai)
#pragma unroll
                for (int m = 0; m < 4; ++m) rs[ai][m] = cscale; }
        f32x4 bv[2][2];
#pragma unroll
        for (int bj = 0; bj < 2; ++bj)
#pragma unroll
            for (int n = 0; n < 2; ++n) bv[bj][n] = bias ? *(const GAS f32x4*)(bias + col0 + bj * HALF + 4 * n) : (f32x4){0.f, 0.f, 0.f, 0.f};
#pragma unroll
        for (int ai = 0; ai < 2; ++ai)
#pragma unroll
            for (int m = 0; m < 4; ++m) { bf16* rowp = O + (size_t)(rowt + ai * HALF + m * 16) * ldc + col0; const float r = rs[ai][m];
#pragma unroll
                for (int bj = 0; bj < 2; ++bj) { const f32x4 v0 = acc[ai][bj][m][0] * r + bv[bj][0], v1 = acc[ai][bj][m][1] * r + bv[bj][1];
                    u32x4 w; w.x = cvt_pk_bf16(v0[0], v0[1]); w.y = cvt_pk_bf16(v0[2], v0[3]); w.z = cvt_pk_bf16(v1[0], v1[1]); w.w = cvt_pk_bf16(v1[2], v1[3]);
                    *(GAS u32x4*)(rowp + bj * HALF) = w; } }
    }
};
struct EpiSoftmax {
    static constexpr bool PERM = true;
    bf16* P; const float* ssq;
    __device__ __forceinline__ void operator()(f32x4 (&acc)[2][2][4][2], const Unit& u, int wr, int wc, int fr, int fq, LAS unsigned char* xl, int, int) const {
        const int rowt = u.pm * BM + wr * 64 + fr, col0 = u.pn * BM + wc * 32 + 8 * fq;
        LAS f32x2* X = (LAS f32x2*)xl;
        float ml[2][4], rs[2][4];
        rstd8(ssq, rowt, fq, rs, 1.0f);
#pragma unroll
        for (int ai = 0; ai < 2; ++ai)
#pragma unroll
            for (int m = 0; m < 4; ++m) {
                const float r = rs[ai][m];
                float mx = -3.0e38f;
#pragma unroll
                for (int bj = 0; bj < 2; ++bj)
#pragma unroll
                    for (int n = 0; n < 2; ++n) { f32x4 v = acc[ai][bj][m][n] * r; acc[ai][bj][m][n] = v; mx = fmaxf(fmaxf(fmaxf(v[0], v[1]), fmaxf(v[2], v[3])), mx); }
                mx = fmaxf(mx, __shfl_xor(mx, 16)); mx = fmaxf(mx, __shfl_xor(mx, 32));
                float l = 0.f;
#pragma unroll
                for (int bj = 0; bj < 2; ++bj)
#pragma unroll
                    for (int n = 0; n < 2; ++n) { f32x4 v = acc[ai][bj][m][n]; v[0] = __builtin_amdgcn_exp2f(v[0] - mx); v[1] = __builtin_amdgcn_exp2f(v[1] - mx); v[2] = __builtin_amdgcn_exp2f(v[2] - mx); v[3] = __builtin_amdgcn_exp2f(v[3] - mx);
                        acc[ai][bj][m][n] = v; l += (v[0] + v[1]) + (v[2] + v[3]); }
                l += __shfl_xor(l, 16); l += __shfl_xor(l, 32);
                ml[ai][m] = mx;
                if (fq == 0) X[(ai * HALF + wr * 64 + m * 16 + fr) * 4 + wc] = (f32x2){mx, l};
            }
        asm volatile("s_waitcnt lgkmcnt(0)" ::: "memory"); __builtin_amdgcn_s_barrier(); asm volatile("" ::: "memory");
#pragma unroll
        for (int ai = 0; ai < 2; ++ai)
#pragma unroll
            for (int m = 0; m < 4; ++m) {
                const LAS f32x2* xr = X + (ai * HALF + wr * 64 + m * 16 + fr) * 4;
                const f32x2 a = xr[0], b = xr[1], c = xr[2], d = xr[3];
                const float M = fmaxf(fmaxf(a.x, b.x), fmaxf(c.x, d.x));
                const float L = (a.y * __builtin_amdgcn_exp2f(a.x - M) + b.y * __builtin_amdgcn_exp2f(b.x - M)) + (c.y * __builtin_amdgcn_exp2f(c.x - M) + d.y * __builtin_amdgcn_exp2f(d.x - M));
                const float f = __builtin_amdgcn_exp2f(ml[ai][m] - M) / L;
                bf16* rowp = P + (size_t)(rowt + ai * HALF + m * 16) * DM + col0;
#pragma unroll
                for (int bj = 0; bj < 2; ++bj) { const f32x4 v0 = acc[ai][bj][m][0] * f, v1 = acc[ai][bj][m][1] * f;
                    u32x4 w; w.x = cvt_pk_bf16(v0[0], v0[1]); w.y = cvt_pk_bf16(v0[2], v0[3]); w.z = cvt_pk_bf16(v1[0], v1[1]); w.w = cvt_pk_bf16(v1[2], v1[3]);
                    *(GAS u32x4*)(rowp + bj * HALF) = w; }
            }
    }
};
struct EpiResidual {
    static constexpr bool PERM = false;
    const float* xold; float* xnew; bf16* xb; const float* bias; float* ssq;
    __device__ __forceinline__ void operator()(f32x4 (&acc)[2][2][4][2], const Unit& u, int wr, int wc, int fr, int fq, LAS unsigned char*, int, int) const {
        const int row0 = u.pm * BM + wr * 64 + fr, col0 = u.pn * BM + wc * 32 + 4 * fq;
        f32x4 bv[2][2];
#pragma unroll
        for (int bj = 0; bj < 2; ++bj)
#pragma unroll
            for (int n = 0; n < 2; ++n) bv[bj][n] = *(const GAS f32x4*)(bias + col0 + bj * HALF + n * 16);
#pragma unroll
        for (int ai = 0; ai < 2; ++ai)
#pragma unroll
            for (int m = 0; m < 4; ++m) { int row = row0 + ai * HALF + m * 16; asm volatile("" : "+v"(row)); const size_t off = (size_t)row * DM + col0; float sq = 0.f;
#pragma unroll
                for (int bj = 0; bj < 2; ++bj)
#pragma unroll
                    for (int n = 0; n < 2; ++n) { const f32x4 xo = *(const GAS f32x4*)(xold + off + bj * HALF + n * 16); const f32x4 v = (acc[ai][bj][m][n] + bv[bj][n]) + xo;
                        *(GAS f32x4*)(xnew + off + bj * HALF + n * 16) = v; sq += (v[0] * v[0] + v[1] * v[1]) + (v[2] * v[2] + v[3] * v[3]);
                        u32x2 w; w.x = cvt_pk_bf16(v[0], v[1]); w.y = cvt_pk_bf16(v[2], v[3]); *(GAS u32x2*)(xb + off + bj * HALF + n * 16) = w; }
                sq += __shfl_xor(sq, 16); sq += __shfl_xor(sq, 32);
                if (fq == 0) *(GAS float*)(ssq + (size_t)row * 16 + u.pn * 4 + wc) = sq;
                asm volatile("" ::: "memory"); }
    }
};

template <class Epi, class Sched>
__device__ __forceinline__ void gemm_phase(LAS unsigned char* lds, LAS unsigned char* xl, const Gemm g, const Sched& S, const Epi& E, const int tid) {
    const int wid = __builtin_amdgcn_readfirstlane(tid >> 6), lane = tid & 63, wr = wid >> 2, wc = wid & 3, fr = lane & 15, fq = lane >> 4;
    const int K = g.K, nt = K / BK;
    unsigned voffA[2], voffB[2];
#pragma unroll
    for (int i = 0; i < 2; ++i) { int R, C; stage_rc(tid * 16 + i * 8192, R, C); const int Rb = Epi::PERM ? ((R & ~31) + perm32(R & 31)) : R;
        voffA[i] = (unsigned)(R * g.lda + C) * 2u; voffB[i] = (unsigned)(Rb * g.ldb + C) * 2u; }
    const size_t kstep = (size_t)(BK * 2);
    const size_t hstepA = (size_t)HALF * g.lda * 2, hstepB = (size_t)HALF * g.ldb * 2;
    const unsigned ldsw = (unsigned)wid * 1024u;
    const int aoff = lds_byte(wr * 64 + fr, fq * 8), boff = lds_byte(wc * 32 + fr, fq * 8);
#define PG8_SA(b, h) (((b) * 2 + (h)) * HTB)
#define PG8_SB(b, h) ((4 + (b) * 2 + (h)) * HTB)
#define PG8_STAGE(bufoff, gbase, voff) do { _Pragma("unroll") for (int _i = 0; _i < 2; ++_i) \
        __builtin_amdgcn_global_load_lds((const unsigned*)((const char*)(gbase) + (voff)[_i]), (LAS unsigned*)(lds + (bufoff) + ldsw + _i * 8192), 16, 0, 0); } while (0)
#define PG8_LDA(dst, b, h) do { _Pragma("unroll") for (int m = 0; m < 4; ++m) _Pragma("unroll") for (int k = 0; k < 2; ++k) dst[m][k] = *(const LAS bf16x8*)(lds + PG8_SA(b, h) + aoff + m * 2048 + k * 1024); } while (0)
#define PG8_LDB(dst, b, h) do { _Pragma("unroll") for (int n = 0; n < 2; ++n) _Pragma("unroll") for (int k = 0; k < 2; ++k) dst[n][k] = *(const LAS bf16x8*)(lds + PG8_SB(b, h) + boff + n * 2048 + k * 1024); } while (0)
#define PG8_MMA(ai, bj, At, Bt) do { __builtin_amdgcn_s_setprio(1); _Pragma("unroll") for (int m = 0; m < 4; ++m) _Pragma("unroll") for (int n = 0; n < 2; ++n) _Pragma("unroll") for (int k = 0; k < 2; ++k) \
        acc[ai][bj][m][n] = __builtin_amdgcn_mfma_f32_16x16x32_bf16(Bt[n][k], At[m][k], acc[ai][bj][m][n], 0, 0, 0); __builtin_amdgcn_s_setprio(0); } while (0)
#define PG8_WAIT_V(n) asm volatile("s_waitcnt vmcnt(" #n ")" ::: "memory")
#define PG8_WAIT_L(n) asm volatile("s_waitcnt lgkmcnt(" #n ")" ::: "memory")
#define PG8_BAR __builtin_amdgcn_s_barrier()
#define PG8_SCHED __builtin_amdgcn_sched_barrier(0)
    Unit cur, nxt; int ui = 0;
    if (!S.next(0, cur)) return;
    f32x4 acc[2][2][4][2];
#pragma unroll
    for (int a = 0; a < 2; ++a)
#pragma unroll
        for (int b = 0; b < 2; ++b)
#pragma unroll
            for (int m = 0; m < 4; ++m)
#pragma unroll
                for (int n = 0; n < 2; ++n) acc[a][b][m][n] = (f32x4){0.f, 0.f, 0.f, 0.f};
    bf16x8 At[4][2], B0[2][2], B1[2][2];
    const char* cA = (const char*)(g.A + g.ma.off(cur)); const char* cB = (const char*)(g.Bt + g.mb.off(cur));
    PG8_STAGE(PG8_SB(0, 0), cB, voffB); PG8_STAGE(PG8_SB(0, 1), cB + hstepB, voffB); PG8_STAGE(PG8_SA(0, 0), cA, voffA); PG8_STAGE(PG8_SA(0, 1), cA + hstepA, voffA);
    if (wr == 1) PG8_BAR;
    PG8_WAIT_V(2); PG8_BAR;
    PG8_STAGE(PG8_SB(1, 0), cB + kstep, voffB); PG8_STAGE(PG8_SA(1, 0), cA + kstep, voffA); PG8_STAGE(PG8_SB(1, 1), cB + hstepB + kstep, voffB);
    PG8_WAIT_V(6); PG8_BAR;
    for (;;) {
        const bool has_next = S.next(ui + 1, nxt);
        const char* nA = has_next ? (const char*)(g.A + g.ma.off(nxt)) : cA; const char* nB = has_next ? (const char*)(g.Bt + g.mb.off(nxt)) : cB;
        for (int t = 0; t < nt; t += 2) {
            const bool last = (t == nt - 2);
            const char* a1 = cA + (size_t)(t + 1) * kstep;
            const char* a2 = last ? nA : cA + (size_t)(t + 2) * kstep; const char* b2 = last ? nB : cB + (size_t)(t + 2) * kstep;
            const char* a3 = a2 + kstep; const char* b3 = b2 + kstep;
            PG8_LDB(B0, 0, 0); PG8_LDB(B1, 0, 1); PG8_SCHED; PG8_LDA(At, 0, 0); PG8_STAGE(PG8_SA(1, 1), a1 + hstepA, voffA);
            PG8_WAIT_V(8); PG8_WAIT_L(0); PG8_BAR; PG8_MMA(0, 0, At, B0); PG8_MMA(0, 1, At, B1); PG8_BAR; PG8_SCHED;
            PG8_LDA(At, 0, 1); PG8_STAGE(PG8_SB(0, 0), b2, voffB); PG8_STAGE(PG8_SB(0, 1), b2 + hstepB, voffB); PG8_STAGE(PG8_SA(0, 0), a2, voffA);
            PG8_WAIT_V(8); PG8_WAIT_L(0); PG8_BAR; PG8_MMA(1, 0, At, B0); PG8_MMA(1, 1, At, B1); PG8_BAR; PG8_SCHED;
            PG8_LDB(B0, 1, 0); PG8_LDB(B1, 1, 1); PG8_SCHED; PG8_LDA(At, 1, 0); PG8_STAGE(PG8_SA(0, 1), a2 + hstepA, voffA);
            PG8_WAIT_V(8); PG8_WAIT_L(0); PG8_BAR; PG8_MMA(0, 0, At, B0); PG8_MMA(0, 1, At, B1); PG8_BAR; PG8_SCHED;
            PG8_LDA(At, 1, 1); PG8_STAGE(PG8_SB(1, 0), b3, voffB); PG8_STAGE(PG8_SB(1, 1), b3 + hstepB, voffB); PG8_STAGE(PG8_SA(1, 0), a3, voffA);
            PG8_WAIT_V(8); PG8_WAIT_L(0); PG8_BAR; PG8_MMA(1, 0, At, B0); PG8_MMA(1, 1, At, B1); PG8_BAR; PG8_SCHED;
        }
        if (wr == 0) PG8_BAR;
        { int fr_ = fr, fq_ = fq, lane_ = lane; asm volatile("" : "+v"(fr_), "+v"(fq_), "+v"(lane_));
          E(acc, cur, wr, wc, fr_, fq_, xl, wid, lane_); }
        if (!has_next) break;
#pragma unroll
        for (int a = 0; a < 2; ++a)
#pragma unroll
            for (int b = 0; b < 2; ++b)
#pragma unroll
                for (int m = 0; m < 4; ++m)
#pragma unroll
                    for (int n = 0; n < 2; ++n) acc[a][b][m][n] = (f32x4){0.f, 0.f, 0.f, 0.f};
        cur = nxt; cA = nA; cB = nB; ++ui;
        if (wr == 1) PG8_BAR;
    }
    PG8_WAIT_V(0);
    PG8_BAR;
#undef PG8_SA
#undef PG8_SB
#undef PG8_STAGE
#undef PG8_LDA
#undef PG8_LDB
#undef PG8_MMA
#undef PG8_WAIT_V
#undef PG8_WAIT_L
#undef PG8_BAR
#undef PG8_SCHED
}
}

typedef GAS unsigned gu32;
#define RLX_AGENT __ATOMIC_RELAXED, __HIP_MEMORY_SCOPE_AGENT
#define LDS_WAIT() asm volatile("s_waitcnt lgkmcnt(0)" ::: "memory")
#define VM_WAIT() asm volatile("s_waitcnt vmcnt(0)" ::: "memory")
__device__ __forceinline__ unsigned f2bf(float f) { unsigned u = __builtin_bit_cast(unsigned, f); return (u + 0x7fffu + ((u >> 16) & 1u)) >> 16; }
__device__ __forceinline__ unsigned pk2(float lo, float hi) { return f2bf(lo) | (f2bf(hi) << 16); }
__device__ __forceinline__ float bf2f(unsigned short h) { return __builtin_bit_cast(float, (unsigned)h << 16); }
__device__ __forceinline__ float bflo(unsigned w) { return __builtin_bit_cast(float, w << 16); }
__device__ __forceinline__ float bfhi(unsigned w) { return __builtin_bit_cast(float, w & 0xffff0000u); }
__device__ __forceinline__ float wave_sum(float v) {
#pragma unroll
    for (int o = 1; o < 64; o <<= 1) v += __shfl_xor(v, o);
    return v;
}
__device__ __forceinline__ float wave_max(float v) {
#pragma unroll
    for (int o = 1; o < 64; o <<= 1) v = fmaxf(v, __shfl_xor(v, o));
    return v;
}
__device__ __forceinline__ float gelu_tanh(float x) { const float u = 0.7978845608028654f * (x + 0.044715f * x * x * x); return x / (1.0f + __expf(-2.0f * u)); }
__device__ __forceinline__ float silu(float x) { return x / (1.0f + __expf(-x)); }

#define XB_TMO      128
#define XB_XCNT(j)  (256  + 64 * (j))
#define XB_XSUB(j)  (1280 + 64 * (j))
#define XB_XGEN(j)  (2304 + 64 * (j))
#define XB_TOP      3328
#define XB_TOPGEN   3392
#define XCD_BAR_WORDS 3456
#define XB_SPIN_CAP (1u << 18)
__device__ __forceinline__ unsigned xb_ld(unsigned* p)              { return __hip_atomic_load(p, __ATOMIC_RELAXED, __HIP_MEMORY_SCOPE_AGENT); }
__device__ __forceinline__ unsigned xb_add(unsigned* p, unsigned v) { return __hip_atomic_fetch_add(p, v, __ATOMIC_RELAXED, __HIP_MEMORY_SCOPE_AGENT); }
__device__ __forceinline__ unsigned xb_xcc_id() { return (unsigned)__builtin_amdgcn_s_getreg((3 << 11) | 20) & 0xFu; }
#define XB_SPIN(cond, bar) do { unsigned _sp = 0; while (cond) { __builtin_amdgcn_s_sleep(1); \
    if ((++_sp & 255u) == 0u) { if (xb_ld(&(bar)[XB_TMO])) break; if (_sp > XB_SPIN_CAP) { atomicAdd(&(bar)[XB_TMO], 1u); break; } } } } while (0)
struct XcdBarrier { unsigned* bar; unsigned x; volatile LAS unsigned* st; };
__device__ __forceinline__ XcdBarrier xcd_barrier_post(unsigned* bar, volatile LAS unsigned* st) {
    XcdBarrier b; b.bar = bar; b.x = xb_xcc_id(); b.st = st;
    if (threadIdx.x == 0) (void)xb_add(&bar[XB_XCNT(b.x)], 1u);
    return b;
}
__device__ __forceinline__ void xcd_barrier_complete(unsigned* bar, unsigned x, unsigned& nloc, unsigned& nx) {
    const unsigned G = gridDim.x * gridDim.y * gridDim.z;
    unsigned sum, cnt, mine, sp = 0u;
    for (;;) {
        sum = 0u; cnt = 0u; mine = 0u;
#pragma unroll
        for (unsigned j = 0; j < 16; ++j) { const unsigned c = xb_ld(&bar[XB_XCNT(j)]); sum += c; cnt += (c > 0u) ? 1u : 0u; mine = (j == x) ? c : mine; }
        if (sum == G) break;
        __builtin_amdgcn_s_sleep(1);
        if ((++sp & 255u) == 0u) { if (xb_ld(&bar[XB_TMO])) break; if (sp > XB_SPIN_CAP) { atomicAdd(&bar[XB_TMO], 1u); break; } }
    }
    nloc = mine > 0u ? mine : 1u; nx = cnt > 0u ? cnt : 1u;
}
__device__ __forceinline__ void xcd_barrier(const XcdBarrier& b) {
    asm volatile("s_waitcnt vmcnt(0)" ::: "memory");
    __syncthreads();
    if (threadIdx.x == 0) {
        unsigned* bar = b.bar;
        __builtin_amdgcn_s_waitcnt(0);
        unsigned nloc = b.st[0], nx = b.st[1];
        if (nloc == 0u) { xcd_barrier_complete(bar, b.x, nloc, nx); b.st[0] = nloc; b.st[1] = nx; }
        const unsigned old = xb_add(&bar[XB_XSUB(b.x)], 1u);
        const unsigned gen = old / nloc;
        if (old + 1u == (gen + 1u) * nloc) {
            __builtin_amdgcn_fence(__ATOMIC_RELEASE, "agent");
            asm volatile("s_waitcnt vmcnt(0)" ::: "memory");
            const unsigned og = xb_add(&bar[XB_TOP], 1u);
            const unsigned tg = og / nx;
            if (og + 1u == (tg + 1u) * nx) xb_add(&bar[XB_TOPGEN], 1u);
            else XB_SPIN(xb_ld(&bar[XB_TOPGEN]) == tg, bar);
            __builtin_amdgcn_fence(__ATOMIC_ACQUIRE, "agent");
            xb_add(&bar[XB_XGEN(b.x)], 1u);
            asm volatile("s_waitcnt vmcnt(0)" ::: "memory");
        } else {
            XB_SPIN(xb_ld(&bar[XB_XGEN(b.x)]) == gen, bar);
            __builtin_amdgcn_fence(__ATOMIC_ACQUIRE, "agent");
            asm volatile("s_waitcnt vmcnt(0)" ::: "memory");
        }
    }
    __syncthreads();
}

enum { I_X = 0, I_MEM, I_REL, I_MEMG, I_NMIXG, I_WIN, I_BIN, I_VG, I_WS, I_BS, I_PW, I_PB, I_PSC, I_WOUT, I_BOUT, I_NMEMG, I_WQ, I_WKV, I_WO, I_BO, I_NFFNG, I_WUP, I_BUP, I_CW, I_CB, I_WDOWN, I_BDOWN, I_FNG, N_IN };
struct Args { const float* in[N_IN]; float* out; unsigned char* ws; int ph_lo, ph_hi; };
constexpr int PH_PRO = 0, PH_KV = 1, PH_QV = 2, PH_L0 = 3, PH_PER_LAYER = 15, PH_FINAL = PH_L0 + 2 * PH_PER_LAYER, N_PHASES = PH_FINAL + 1;

struct Ctx {
    LAS unsigned char* lds; int tid, lane, wave, G, bid;
    const float* const* in; float* out; unsigned char* ws;
    __device__ __forceinline__ bf16* wl(int l, size_t off) const { return (bf16*)(ws + WS_W + (size_t)l * WL_STRIDE + off); }
};

__device__ __forceinline__ void tr_item(const float* W, int ldw, const float* gain, bf16* WT, int K, int k0, int n0, int drow0, LAS float* scr, int lane, float cs = 1.0f) {
#pragma unroll 8
    for (int i = 0; i < 32; ++i) { const int kk = 2 * i + (lane >> 5); float v = W[(size_t)(k0 + kk) * ldw + n0 + (lane & 31)] * cs; if (gain) v *= gain[k0 + kk]; scr[kk * 33 + (lane & 31)] = v; }
    LDS_WAIT(); asm volatile("" ::: "memory");
    const int c = lane & 7;
#pragma unroll
    for (int j = 0; j < 4; ++j) { const int n = (lane >> 3) + 8 * j; const LAS float* s = scr + (8 * c) * 33 + n;
        u32x4 o; o.x = pk2(s[0 * 33], s[1 * 33]); o.y = pk2(s[2 * 33], s[3 * 33]); o.z = pk2(s[4 * 33], s[5 * 33]); o.w = pk2(s[6 * 33], s[7 * 33]);
        *(u32x4*)(WT + (size_t)(drow0 + n) * K + k0 + 8 * c) = o; }
    LDS_WAIT(); asm volatile("" ::: "memory");
}
__device__ __forceinline__ void phase_prologue(const Ctx& C) {
    LAS float* scr = (LAS float*)(C.lds + C.wave * 16384);
    const int gw = C.bid * 8 + C.wave, NGW = C.G * 8, lane = C.lane;
    constexpr int I_IN = 16 * 68, I_OUT = 12 * 32, I_KV = 16 * 64, I_O = 16 * 32, I_UP = 16 * 176, I_DN = 44 * 32, I_L = I_IN + I_OUT + I_KV + I_O + I_UP + I_DN;
    for (int it = gw; it < 2 * I_L; it += NGW) {
        const int l = it / I_L; int r = it % I_L;
        if (r < I_IN) { const int kb = r / 68, nb = r % 68; tr_item(C.in[I_WIN] + (size_t)l * DM * INW, INW, C.in[I_NMIXG] + l * DM, C.wl(l, WL_WIN), DM, kb * 64, nb * 32, nb * 32, scr, lane, (nb * 32 >= 1024 && nb * 32 < 1408) ? QSCALE : 1.0f); continue; } r -= I_IN;
        if (r < I_OUT) { const int kb = r / 32, nb = r % 32; tr_item(C.in[I_WOUT] + (size_t)l * OUTW * DM, DM, nullptr, C.wl(l, WL_WOUT), OUTW, kb * 64, nb * 32, nb * 32, scr, lane); continue; } r -= I_OUT;
        if (r < I_KV) { const int kb = r / 64, nb = r % 64; tr_item(C.in[I_WKV] + (size_t)l * DM * 2048, 2048, nullptr, (bf16*)(C.ws + WS_WKVT) + (size_t)l * 2048 * DM, DM, kb * 64, nb * 32, nb * 32, scr, lane); continue; } r -= I_KV;
        if (r < I_O) { const int kb = r / 32, nb = r % 32; tr_item(C.in[I_WO] + (size_t)l * DM * DM, DM, nullptr, (bf16*)(C.ws + WS_WOT) + (size_t)l * DM * DM, DM, kb * 64, nb * 32, nb * 32, scr, lane); continue; } r -= I_O;
        if (r < I_UP) { const int kb = r / 176, nb = r % 176; const int n0 = nb * 32; const int drow = n0 < DFF ? (n0 / 128) * 256 + (n0 % 128) : ((n0 - DFF) / 128) * 256 + 128 + ((n0 - DFF) % 128);
            tr_item(C.in[I_WUP] + (size_t)l * DM * DFF2, DFF2, C.in[I_NFFNG] + l * DM, C.wl(l, WL_WUP), DM, kb * 64, n0, drow, scr, lane); continue; } r -= I_UP;
        { const int kb = r / 32, nb = r % 32; tr_item(C.in[I_WDOWN] + (size_t)l * DFF * DM, DM, nullptr, C.wl(l, WL_WDOWN), DFF, kb * 64, nb * 32, nb * 32, scr, lane); }
    }
    for (int i = gw * 64 + lane; i < 2 * (INWP - INW) * DM / 8; i += NGW * 64) { const int l = i / ((INWP - INW) * DM / 8), j = i % ((INWP - INW) * DM / 8);
        unsigned z0 = 0u; asm volatile("" : "+v"(z0)); *((u32x4*)(C.wl(l, WL_WIN) + (size_t)INW * DM) + j) = (u32x4){z0, z0, z0, z0}; }
    for (int r = gw; r < 2 * DM; r += NGW) { const int l = r / DM, k = r % DM; const float gk = C.in[I_NMEMG][l * DM + k];
        const f32x4* src = (const f32x4*)(C.in[I_WQ] + (size_t)l * DM * DM + (size_t)k * DM); u32x2* dst = (u32x2*)((bf16*)(C.ws + WS_WQ) + (size_t)l * DM * DM + (size_t)k * DM);
#pragma unroll
        for (int j = 0; j < 4; ++j) { const f32x4 v = src[lane + 64 * j] * gk; u32x2 w; w.x = pk2(v[0], v[1]); w.y = pk2(v[2], v[3]); dst[lane + 64 * j] = w; } }
    for (int r = gw; r < TOK; r += NGW) { const f32x4* src = (const f32x4*)(C.in[I_X] + (size_t)r * DM); u32x2* dst = (u32x2*)((bf16*)(C.ws + WS_XB) + (size_t)r * DM); float s = 0.f;
#pragma unroll
        for (int j = 0; j < 4; ++j) { const f32x4 v = src[lane + 64 * j]; s += (v[0] * v[0] + v[1] * v[1]) + (v[2] * v[2] + v[3] * v[3]); u32x2 w; w.x = pk2(v[0], v[1]); w.y = pk2(v[2], v[3]); dst[lane + 64 * j] = w; }
        s = wave_sum(s); if (lane < 16) ((float*)(C.ws + WS_SSQ))[(size_t)r * 16 + lane] = lane == 0 ? s : 0.f; }
    for (int r = gw; r < MEMR; r += NGW) { const f32x4* src = (const f32x4*)(C.in[I_MEM] + (size_t)r * DM); const f32x4* gg = (const f32x4*)C.in[I_MEMG]; u32x2* dst = (u32x2*)((bf16*)(C.ws + WS_MEMN) + (size_t)r * DM);
        f32x4 v[4]; float s = 0.f;
#pragma unroll
        for (int j = 0; j < 4; ++j) { v[j] = src[lane + 64 * j]; s += (v[j][0] * v[j][0] + v[j][1] * v[j][1]) + (v[j][2] * v[j][2] + v[j][3] * v[j][3]); }
        const float rs = 1.0f / sqrtf(wave_sum(s) * (1.0f / DM) + EPS);
#pragma unroll
        for (int j = 0; j < 4; ++j) { const f32x4 o = v[j] * rs * gg[lane + 64 * j]; u32x2 w; w.x = pk2(o[0], o[1]); w.y = pk2(o[2], o[3]); dst[lane + 64 * j] = w; } }
    float* tab = (float*)(C.ws + WS_TAB);
    for (int i = C.bid * 512 + C.tid; i < 2 * INWP; i += C.G * 512) { const int l = i / INWP, c = i % INWP; tab[i] = c < INW ? C.in[I_BIN][l * INW + c] * ((c >= 1024 && c < 1408) ? QSCALE : 1.0f) : 0.f; }
    for (int i = C.bid * 512 + C.tid; i < 2 * DFF2; i += C.G * 512) { const int l = i / DFF2, c = i % DFF2; const int t = c >> 8, w = c & 255; const int src = w < 128 ? t * 128 + w : DFF + t * 128 + (w - 128);
        tab[2 * INWP + i] = C.in[I_BUP][l * DFF2 + src]; }
}

__device__ __forceinline__ int t5_bucket(int rel) {
    const int n = rel < 0 ? -rel : rel; int b = rel > 0 ? 16 : 0;
    if (n < 8) return b + n;
    return b + 8 + (n >= 15) + (n >= 27) + (n >= 50) + (n >= 91) + (n >= 166) + (n >= 305) + (n >= 559);
}
namespace att {
typedef float f32x16 __attribute__((ext_vector_type(16)));
typedef short s16x4 __attribute__((ext_vector_type(4)));
typedef __bf16 bf16x2_t __attribute__((ext_vector_type(2)));
__device__ __forceinline__ unsigned cvtpk(float lo, float hi) { f32x2 v = {lo, hi}; bf16x2_t b = __builtin_convertvector(v, bf16x2_t); return __builtin_bit_cast(unsigned, b); }
__device__ __forceinline__ s16x4 vtr(const LAS unsigned char* p) { return __builtin_bit_cast(s16x4, __builtin_amdgcn_ds_read_tr16_b64_v4i16((LAS s16x4*)p)); }
constexpr int OFF_K = 0, OFF_V = 49152, OFF_WS = 98304, OFF_TAB = 102400;
template <bool MERGE>
__device__ __forceinline__ void unit(const Ctx& C, int g, int b, int h, int r, int blk) {
    const int tid = C.tid, lane = C.lane, wid = C.wave, r32 = lane & 31, hi = lane >> 5;
    const int d = 1 << (2 * g), L = SEQ >> (2 * g), q0 = blk * 256;
    const bf16* z = (const bf16*)(C.ws + WS_Z);
    const bf16* zb = z + ((size_t)b * SEQ + r) * INWP; const size_t rp = (size_t)d * INWP;
    const int colq = 1024 + g * 128 + h * 64, colk = 1408 + g * 128 + h * 64, colv = 1792 + g * 128 + h * 64;
    LAS unsigned char* lds = C.lds;
    LAS float* tabL = (LAS float*)(lds + OFF_TAB);
    if (tid < 255) { const int dl = tid - 127; float v = -3.0e38f; if (dl >= -64 && dl <= 64) v = C.in[I_REL][t5_bucket(dl * d) * 6 + g * 2 + h] * LOG2E; tabL[tid] = v; }
#pragma unroll
    for (int t = 0; t < 6; ++t) {
        int ki = q0 - 64 + 64 * t + lane; ki = ki < 0 ? 0 : (ki >= L ? L - 1 : ki);
        __builtin_amdgcn_global_load_lds((const unsigned*)(zb + (size_t)ki * rp + colk + wid * 8), (LAS unsigned*)(lds + OFF_K + t * 8192 + wid * 1024), 16, 0, 0);
        int vi = q0 - 64 + 64 * t + 16 * (wid & 3) + (lane >> 2); vi = vi < 0 ? 0 : (vi >= L ? L - 1 : vi);
        __builtin_amdgcn_global_load_lds((const unsigned*)(zb + (size_t)vi * rp + colv + (wid >> 2) * 32 + (lane & 3) * 8), (LAS unsigned*)(lds + OFF_V + t * 8192 + wid * 1024), 16, 0, 0);
    }
    bf16x8 qr[4];
    { const bf16* qp = zb + (size_t)(q0 + 32 * wid + r32) * rp + colq + hi * 8;
#pragma unroll
      for (int d0 = 0; d0 < 4; ++d0) qr[d0] = *(const GAS bf16x8*)(qp + d0 * 16); }
    asm volatile("s_waitcnt vmcnt(0)" ::: "memory"); __syncthreads();
    const int tb = wid >> 1;
    f32x16 S[3][2];
#pragma unroll
    for (int tt = 0; tt < 3; ++tt) {
        const LAS unsigned char* Ks = lds + OFF_K + (tb + tt) * 8192 + hi * 1024 + r32 * 16;
#pragma unroll
        for (int p = 0; p < 2; ++p)
#pragma unroll
            for (int i = 0; i < 16; ++i) S[tt][p][i] = 0.f;
#pragma unroll
        for (int d0 = 0; d0 < 4; ++d0) { const bf16x8 k0 = *(const LAS bf16x8*)(Ks + d0 * 2048), k1 = *(const LAS bf16x8*)(Ks + d0 * 2048 + 512);
            S[tt][0] = __builtin_amdgcn_mfma_f32_32x32x16_bf16(k0, qr[d0], S[tt][0], 0, 0, 0); S[tt][1] = __builtin_amdgcn_mfma_f32_32x32x16_bf16(k1, qr[d0], S[tt][1], 0, 0, 0); }
    }
    { const LAS float* tp = tabL + (4 * hi - r32 - 32 * (wid & 1) + 63);
      const bool edge = (blk == 0) || (q0 + 256 >= L); const int kb = q0 - 64 + 64 * tb + 4 * hi;
      float mx = -3.0e38f;
#pragma unroll
      for (int tt = 0; tt < 3; ++tt)
#pragma unroll
          for (int p = 0; p < 2; ++p)
#pragma unroll
              for (int i = 0; i < 16; ++i) { const int cr = 64 * tt + 32 * p + (i & 3) + 8 * (i >> 2); float v = S[tt][p][i] + tp[cr];
                  if (edge) { const int kidx = kb + cr; if (kidx < 0 || kidx >= L) v = -3.0e38f; }
                  S[tt][p][i] = v; mx = fmaxf(mx, v); }
      mx = fmaxf(mx, __shfl_xor(mx, 32));
      float l = 0.f;
#pragma unroll
      for (int tt = 0; tt < 3; ++tt)
#pragma unroll
          for (int p = 0; p < 2; ++p)
#pragma unroll
              for (int i = 0; i < 16; ++i) { const float e = __builtin_amdgcn_exp2f(S[tt][p][i] - mx); S[tt][p][i] = e; l += e; }
      l += __shfl_xor(l, 32);
      LAS float* wsf = (LAS float*)(lds + OFF_WS) + wid * 128;
      const int tokq = b * SEQ + r + d * (q0 + 32 * wid + r32);
      if (!MERGE) { if (hi == 0) { wsf[r32] = 1.0f / l; ((float*)(C.ws + WS_LSE))[((size_t)(g - 1) * TOK + tokq) * 2 + h] = mx + __builtin_amdgcn_logf(l); } }
      else if (hi == 0) { const float* lse = (const float*)(C.ws + WS_LSE); const float l0 = mx + __builtin_amdgcn_logf(l), l1 = lse[(size_t)tokq * 2 + h], l2 = lse[((size_t)TOK + tokq) * 2 + h];
          const float M = fmaxf(fmaxf(l0, l1), l2); const float w0 = __builtin_amdgcn_exp2f(l0 - M), w1 = __builtin_amdgcn_exp2f(l1 - M), w2 = __builtin_amdgcn_exp2f(l2 - M); const float iw = 1.0f / (w0 + w1 + w2);
          wsf[r32] = w0 * iw / l; wsf[32 + r32] = w1 * iw; wsf[64 + r32] = w2 * iw; }
    }
    f32x16 o[2];
#pragma unroll
    for (int i = 0; i < 16; ++i) { o[0][i] = 0.f; o[1][i] = 0.f; }
    { const LAS unsigned char* vp0 = lds + OFF_V + ((lane >> 4) & 1) * 32 + (lane & 3) * 8 + (4 * hi + ((lane & 15) >> 2)) * 64;
#pragma unroll
      for (int tt = 0; tt < 3; ++tt) { const LAS unsigned char* vt = vp0 + (tb + tt) * 8192;
#pragma unroll
          for (int ks = 0; ks < 4; ++ks) { const f32x16& P = S[tt][ks >> 1]; const int rb = (ks & 1) * 8;
              u32x4 pw; pw.x = cvtpk(P[rb + 0], P[rb + 1]); pw.y = cvtpk(P[rb + 2], P[rb + 3]); pw.z = cvtpk(P[rb + 4], P[rb + 5]); pw.w = cvtpk(P[rb + 6], P[rb + 7]);
              const bf16x8 pa = __builtin_bit_cast(bf16x8, pw);
#pragma unroll
              for (int dh = 0; dh < 2; ++dh) { const s16x4 lo = vtr(vt + dh * 4096 + ks * 1024), hi4 = vtr(vt + dh * 4096 + ks * 1024 + 512);
                  const bf16x8 vf = (bf16x8){lo[0], lo[1], lo[2], lo[3], hi4[0], hi4[1], hi4[2], hi4[3]};
                  o[dh] = __builtin_amdgcn_mfma_f32_32x32x16_bf16(pa, vf, o[dh], 0, 0, 0); } } }
    }
    asm volatile("s_waitcnt lgkmcnt(0)" ::: "memory"); __syncthreads();
    { LAS float* stg = (LAS float*)(lds + wid * 8192); const LAS float* wsf = (const LAS float*)(lds + OFF_WS) + wid * 128;
#pragma unroll
      for (int i = 0; i < 16; ++i) { const int q = (i & 3) + 8 * (i >> 2) + 4 * hi; stg[q * 64 + r32] = o[0][i]; stg[q * 64 + 32 + r32] = o[1][i]; }
      asm volatile("s_waitcnt lgkmcnt(0)" ::: "memory");
#pragma unroll
      for (int it = 0; it < 4; ++it) { const int row = it * 8 + (lane >> 3), ch = lane & 7; const size_t tok = (size_t)b * SEQ + r + (size_t)d * (q0 + 32 * wid + row);
          const f32x4 a0 = *(const LAS f32x4*)(stg + row * 64 + ch * 8), a1 = *(const LAS f32x4*)(stg + row * 64 + ch * 8 + 4); const float c0 = wsf[row];
          float v[8] = {a0[0] * c0, a0[1] * c0, a0[2] * c0, a0[3] * c0, a1[0] * c0, a1[1] * c0, a1[2] * c0, a1[3] * c0};
          if (MERGE) { const bf16* og = (const bf16*)(C.ws + WS_OG); const float c1 = wsf[32 + row], c2 = wsf[64 + row];
              const u32x4 x1 = *(const GAS u32x4*)(og + tok * 128 + h * 64 + ch * 8), x2 = *(const GAS u32x4*)(og + ((size_t)TOK + tok) * 128 + h * 64 + ch * 8);
#pragma unroll
              for (int e = 0; e < 4; ++e) { v[2 * e] += c1 * bflo(x1[e]) + c2 * bflo(x2[e]); v[2 * e + 1] += c1 * bfhi(x1[e]) + c2 * bfhi(x2[e]); } }
          u32x4 w; w.x = cvtpk(v[0], v[1]); w.y = cvtpk(v[2], v[3]); w.z = cvtpk(v[4], v[5]); w.w = cvtpk(v[6], v[7]);
          if (MERGE) *(GAS u32x4*)((bf16*)(C.ws + WS_Y) + tok * OUTW + 640 + h * 64 + ch * 8) = w;
          else *(GAS u32x4*)((bf16*)(C.ws + WS_OG) + ((size_t)(g - 1) * TOK + tok) * 128 + h * 64 + ch * 8) = w; }
    }
    asm volatile("s_waitcnt lgkmcnt(0)" ::: "memory"); __syncthreads();
}
}
__device__ __forceinline__ void phase_attn12(const Ctx& C) {
    for (int u = C.bid; u < 256; u += C.G) {
        if (u < 128) att::unit<false>(C, 1, u >> 5, (u >> 4) & 1, (u >> 2) & 3, u & 3);
        else { const int v = u - 128; att::unit<false>(C, 2, v >> 5, (v >> 4) & 1, v & 15, 0); }
    }
}

__device__ __forceinline__ void phase_mixer(const Ctx& C, int l) {
    const bf16* z = (const bf16*)(C.ws + WS_Z); bf16* y = (bf16*)(C.ws + WS_Y);
    const int lane = C.lane, wave = C.wave, tid = C.tid;
    {
        LAS float* vn = (LAS float*)C.lds;
        const float* ws_ = C.in[I_WS] + (size_t)l * 6 * 128 * 128; const float* bs_ = C.in[I_BS] + l * 6 * 128; const float* vg = C.in[I_VG] + l * 6 * 64;
        for (int uu = C.bid; uu < NBATCH * 32 * 6; uu += C.G) {
            const int h = uu % 6, n = (uu / 6) % 32, b = uu / 192; const size_t r0 = (size_t)b * SEQ + n * 128;
            for (int i = 0; i < 16; ++i) { const int q = wave * 16 + i; const float val = gelu_tanh(bf2f(z[(r0 + q) * INWP + 384 + h * 64 + lane]));
                const float ss = wave_sum(val * val); vn[q * 64 + lane] = val * (1.0f / sqrtf(ss * (1.0f / 64) + EPS)) * vg[h * 64 + lane]; }
            __syncthreads();
            float vcol[128];
#pragma unroll
            for (int q = 0; q < 128; ++q) vcol[q] = vn[q * 64 + lane];
            for (int i = 0; i < 16; ++i) { const int p = wave * 16 + i; const float* wrow = ws_ + ((size_t)h * 128 + p) * 128; float a = 0.f;
#pragma unroll
                for (int q = 0; q < 128; ++q) a += wrow[q] * vcol[q];
                const float u = gelu_tanh(bf2f(z[(r0 + p) * INWP + h * 64 + lane]));
                y[(r0 + p) * OUTW + h * 64 + lane] = (bf16)f2bf(u * (a + bs_[h * 128 + p])); }
            __syncthreads();
        }
    }
    {
        LAS float* pl = (LAS float*)(C.lds + 32768);
        const float* pw = C.in[I_PW] + (size_t)l * 4 * 64 * 64; const float* pb = C.in[I_PB] + l * 256; const float* psc = C.in[I_PSC] + l * 256;
        for (int uu = C.bid; uu < TOK / 32; uu += C.G) {
            const int r0 = uu * 32; const int c = tid & 255, g = c >> 6, hw = 1 << g;
            for (int i = 0; i < 16; ++i) { const int t = (tid >> 8) * 16 + i; const int row = r0 + t, pos = row & (SEQ - 1), base = row - pos;
                const int lo = pos - hw < 0 ? 0 : pos - hw, hi = pos + hw > SEQ ? SEQ : pos + hw; float s = 0.f;
                for (int p = lo; p < hi; ++p) s += bf2f(z[(size_t)(base + p) * INWP + 768 + c]);
                pl[t * 256 + c] = s / (float)(hi - lo) - bf2f(z[(size_t)row * INWP + 768 + c]); }
            __syncthreads();
            const int f = c & 63; float a16[16];
#pragma unroll
            for (int i = 0; i < 16; ++i) a16[i] = 0.f;
            const float* wp = pw + (g * 64) * 64 + f; const LAS float* plr = pl + (tid >> 8) * 16 * 256 + g * 64;
#pragma unroll 2
            for (int e = 0; e < 64; ++e) { const float w = wp[e * 64];
#pragma unroll
                for (int i = 0; i < 16; ++i) a16[i] += plr[i * 256 + e] * w; }
#pragma unroll
            for (int i = 0; i < 16; ++i) { const int t = (tid >> 8) * 16 + i; y[(size_t)(r0 + t) * OUTW + 384 + c] = (bf16)f2bf((a16[i] + pb[c]) * psc[c]); }
            __syncthreads();
        }
    }
    for (int u = C.bid; u < 128; u += C.G) att::unit<true>(C, 0, u >> 5, (u >> 4) & 1, 0, u & 15);
}

__device__ __forceinline__ void phase_conv(const Ctx& C, int l, int qd) {
    const bf16* uq = (const bf16*)(C.ws + WS_UQ); bf16* gout = (bf16*)(C.ws + WS_G) + (size_t)qd * SEQ * DFF;
    const float* cw = C.in[I_CW] + (size_t)l * 3 * DFF2; const float* cb = C.in[I_CB] + (size_t)l * DFF2;
    const int NI = SEQ * (DFF / 8);
    for (int i = C.bid * 512 + C.tid; i < NI; i += C.G * 512) {
        const int row = i / (DFF / 8), c8 = (i % (DFF / 8)) * 8; const int t = c8 >> 7, w = c8 & 127;
        const bf16* pg = uq + (size_t)row * DFF2 + t * 256 + w; const bf16* pv = pg + 128;
        unsigned z0 = 0u; asm volatile("" : "+v"(z0)); const u32x4 zero = (u32x4){z0, z0, z0, z0};
        const u32x4 g0 = row > 0 ? *(const u32x4*)(pg - DFF2) : zero, g1 = *(const u32x4*)pg, g2 = row < SEQ - 1 ? *(const u32x4*)(pg + DFF2) : zero;
        const u32x4 v0 = row > 0 ? *(const u32x4*)(pv - DFF2) : zero, v1 = *(const u32x4*)pv, v2 = row < SEQ - 1 ? *(const u32x4*)(pv + DFF2) : zero;
        float o[8];
#pragma unroll
        for (int e = 0; e < 8; ++e) { const int cg = c8 + e, cv = DFF + c8 + e;
            const unsigned a0 = g0[e >> 1], a1 = g1[e >> 1], a2 = g2[e >> 1], b0 = v0[e >> 1], b1 = v1[e >> 1], b2 = v2[e >> 1];
            const float ga = (e & 1) ? bfhi(a0) : bflo(a0), gb = (e & 1) ? bfhi(a1) : bflo(a1), gc = (e & 1) ? bfhi(a2) : bflo(a2);
            const float va = (e & 1) ? bfhi(b0) : bflo(b0), vb = (e & 1) ? bfhi(b1) : bflo(b1), vc = (e & 1) ? bfhi(b2) : bflo(b2);
            const float gt = cw[cg] * ga + cw[DFF2 + cg] * gb + cw[2 * DFF2 + cg] * gc + cb[cg];
            const float vl = cw[cv] * va + cw[DFF2 + cv] * vb + cw[2 * DFF2 + cv] * vc + cb[cv];
            o[e] = silu(gt) * vl; }
        u32x4 w4; w4.x = pk2(o[0], o[1]); w4.y = pk2(o[2], o[3]); w4.z = pk2(o[4], o[5]); w4.w = pk2(o[6], o[7]);
        *(u32x4*)(gout + (size_t)row * DFF + c8) = w4;
    }
}

__device__ __forceinline__ void phase_final(const Ctx& C) {
    const int gw = C.bid * 8 + C.wave, NGW = C.G * 8, lane = C.lane; const f32x4* gg = (const f32x4*)C.in[I_FNG];
    for (int r = gw; r < TOK; r += NGW) { f32x4* xr = (f32x4*)(C.out + (size_t)r * DM); f32x4 v[4]; float s = 0.f;
#pragma unroll
        for (int j = 0; j < 4; ++j) { v[j] = xr[lane + 64 * j]; s += (v[j][0] * v[j][0] + v[j][1] * v[j][1]) + (v[j][2] * v[j][2] + v[j][3] * v[j][3]); }
        const float rs = 1.0f / sqrtf(wave_sum(s) * (1.0f / DM) + EPS);
#pragma unroll
        for (int j = 0; j < 4; ++j) xr[lane + 64 * j] = v[j] * rs * gg[lane + 64 * j]; }
}

__device__ __forceinline__ int probe_reps(int ph) {
    if (PROBE_KIND == 0) return 1;
    const int lph = ph >= PH_L0 && ph < PH_FINAL ? (ph - PH_L0) % PH_PER_LAYER : -1;
    bool m = false;
    if (PROBE_KIND == 1) m = lph == 2;
    if (PROBE_KIND == 2) m = lph >= 6 && lph <= 13 && ((lph - 6) & 1);
    if (PROBE_KIND == 3) m = lph >= 6 && lph <= 13 && !((lph - 6) & 1);
    if (PROBE_KIND == 4) m = lph == 0;
    if (PROBE_KIND == 5) m = ph == PH_PRO;
    if (PROBE_KIND == 6) m = lph == 4;
    if (PROBE_KIND == 8) m = lph == 1;
    if (PROBE_KIND == 7) m = ph == PH_KV || ph == PH_QV;
    return m ? 2 : 1;
}
__global__ void __launch_bounds__(512, 2) enc_fwd(Args args) {
    extern __shared__ __attribute__((aligned(16))) unsigned char lds_raw[];
    LAS unsigned char* const lds0 = (LAS unsigned char*)lds_raw;
    volatile LAS unsigned* MISC = (volatile LAS unsigned*)(lds0 + MISC_OFF);
    for (int u = threadIdx.x; u < (LDS_BYTES - LDSCTL_OFF) / 4; u += 512) ((LAS unsigned*)(lds0 + LDSCTL_OFF))[u] = 0u;
    __syncthreads();
    XcdBarrier bar; bar.bar = (unsigned*)(args.ws + WS_CTL) + 4096; bar.x = 0; bar.st = nullptr;
    const int lo = args.ph_lo, hi = args.ph_hi;
    const int wave_s = __builtin_amdgcn_readfirstlane(threadIdx.x >> 6);
    if (hi - lo > 1) bar = xcd_barrier_post((unsigned*)(args.ws + WS_CTL) + 4096, MISC + 8);

    for (int ph = lo; ph < hi; ++ph)
    for (int rep = 0; rep < probe_reps(ph); ++rep) {
        if (ph > lo || rep > 0) xcd_barrier(bar);
        unsigned zero_ = 0u; asm volatile("" : "+v"(zero_));
        int tid_ = wave_s * 64 + (int)__builtin_amdgcn_mbcnt_hi(~0u, __builtin_amdgcn_mbcnt_lo(~0u, zero_));
        unsigned char* ws_ = args.ws; asm volatile("" : "+s"(ws_));
        float* out_ = args.out; asm volatile("" : "+s"(out_));
        Ctx C; C.lds = lds0; C.tid = tid_; C.lane = tid_ & 63; C.wave = wave_s; C.G = gridDim.x; C.bid = blockIdx.x;
        C.in = args.in; C.out = out_; C.ws = ws_;
        LAS unsigned char* ring = C.lds; LAS unsigned char* xl = C.lds + XL_OFF;
        const int G = C.G, bid = C.bid;
        float* ssq = (float*)(C.ws + WS_SSQ); const float* tab = (const float*)(C.ws + WS_TAB);
        bf16* xb = (bf16*)(C.ws + WS_XB);
        if (ph == PH_PRO) { phase_prologue(C); continue; }
        if (ph == PH_FINAL) { phase_final(C); continue; }
        int kind = 0; pg8::Gemm g{}; pg8::StaticOrder S{}; pg8::EpiRowBf16 E0{}; pg8::EpiSoftmax E1{}; pg8::EpiResidual E2{};
        int njobs = 1;
        const int lph = (ph - PH_L0) % PH_PER_LAYER, l = ph >= PH_L0 ? (ph - PH_L0) / PH_PER_LAYER : 0;
        if (ph == PH_KV) njobs = 2; else if (ph == PH_QV) njobs = 4;
        else if (lph == 1) { phase_attn12(C); continue; }
        else if (lph == 2) { phase_mixer(C, l); continue; }
        else if (lph >= 6 && lph <= 13 && ((lph - 6) & 1)) { phase_conv(C, l, (lph - 6) >> 1); continue; }
        for (int job = 0; job < njobs; ++job) {
            if (ph == PH_KV) {
                const int ll = job;
                g.A = (const bf16*)(C.ws + WS_MEMN); g.Bt = (const bf16*)(C.ws + WS_WKVT) + (size_t)ll * 2048 * DM; g.K = DM; g.lda = DM; g.ldb = DM; g.ma = pg8::map_rows(DM); g.mb = pg8::map_cols(DM);
                S.init(4, 8, G, (bid + G - 32 * job) % G);
                kind = 0; E0 = pg8::EpiRowBf16{(bf16*)(C.ws + WS_KV) + (size_t)ll * MEMR * 2048, 2048, nullptr, nullptr, 0, 1.0f};
            } else if (ph == PH_QV) {
                const int ll = job >> 1; const bf16* KV = (const bf16*)(C.ws + WS_KV) + (size_t)ll * MEMR * 2048;
                if ((job & 1) == 0) {
                    g.A = KV; g.lda = 2048; g.ma = pg8::OpMap{2, 3, 0, 0, 256 * 2048, 256, 0, 0};
                    g.Bt = (const bf16*)(C.ws + WS_WQ) + (size_t)ll * DM * DM; g.ldb = DM; g.mb = pg8::OpMap{0, 3, 0, 0, 0, 256, 256 * DM, 0}; g.K = 256;
                    S.init(16, 4, G, (bid + G - 64 * job) % G);
                    kind = 0; E0 = pg8::EpiRowBf16{C.wl(ll, WL_QKT), DM, nullptr, nullptr, 0, 0.0625f * LOG2E};
                } else {
                    g.A = (const bf16*)(C.ws + WS_WOT) + (size_t)ll * DM * DM; g.lda = DM; g.ma = pg8::OpMap{0, 0, 0, 3, 256 * DM, 0, 0, 256};
                    g.Bt = KV + 1024; g.ldb = 2048; g.mb = pg8::OpMap{0, 0, 2, 3, 0, 0, 256 * 2048, 256}; g.K = 256;
                    S.init(4, 16, G, (bid + G - 64 * job) % G);
                    kind = 0; E0 = pg8::EpiRowBf16{C.wl(ll, WL_VOT), 4096, nullptr, nullptr, 0, 1.0f};
                }
            } else if (lph == 0) {
                g.A = xb; g.Bt = C.wl(l, WL_WIN); g.K = DM; g.lda = DM; g.ldb = DM; g.ma = pg8::map_rows(DM); g.mb = pg8::map_cols(DM);
                S.init(64, 9, G, bid); kind = 0; E0 = pg8::EpiRowBf16{(bf16*)(C.ws + WS_Z), INWP, tab + l * INWP, ssq, 0, 1.0f};
            } else if (lph == 3) {
                g.A = (const bf16*)(C.ws + WS_Y); g.Bt = C.wl(l, WL_WOUT); g.K = OUTW; g.lda = OUTW; g.ldb = OUTW; g.ma = pg8::map_rows(OUTW); g.mb = pg8::map_cols(OUTW);
                S.init(64, 4, G, bid); kind = 2; E2 = pg8::EpiResidual{l == 0 ? C.in[I_X] : C.out, C.out, xb, C.in[I_BOUT] + l * DM, ssq};
            } else if (lph == 4) {
                g.A = xb; g.Bt = C.wl(l, WL_QKT); g.K = DM; g.lda = DM; g.ldb = DM; g.ma = pg8::map_rows(DM); g.mb = pg8::OpMap{4, 0, 0, 0, 1024 * 1024, 0, 256 * DM, 0};
                S.init(64, 4, G, bid); kind = 1; E1 = pg8::EpiSoftmax{(bf16*)(C.ws + WS_P), ssq};
            } else if (lph == 5) {
                g.A = (const bf16*)(C.ws + WS_P); g.Bt = C.wl(l, WL_VOT); g.K = DM; g.lda = DM; g.ldb = 4096; g.ma = pg8::map_rows(DM); g.mb = pg8::OpMap{4, 0, 0, 0, 1024, 0, 256 * 4096, 0};
                S.init(64, 4, G, bid); kind = 2; E2 = pg8::EpiResidual{C.out, C.out, xb, C.in[I_BO] + l * DM, ssq};
            } else if (lph >= 6 && lph <= 13) {
                const int qd = (lph - 6) >> 1; g.A = xb + (size_t)qd * SEQ * DM; g.Bt = C.wl(l, WL_WUP); g.K = DM; g.lda = DM; g.ldb = DM; g.ma = pg8::map_rows(DM); g.mb = pg8::map_cols(DM);
                S.init(16, 22, G, bid); kind = 0; E0 = pg8::EpiRowBf16{(bf16*)(C.ws + WS_UQ), DFF2, tab + 2 * INWP + l * DFF2, ssq, qd * SEQ, 1.0f};
            } else {
                g.A = (const bf16*)(C.ws + WS_G); g.Bt = C.wl(l, WL_WDOWN); g.K = DFF; g.lda = DFF; g.ldb = DFF; g.ma = pg8::map_rows(DFF); g.mb = pg8::map_cols(DFF);
                S.init(64, 4, G, bid); kind = 2; E2 = pg8::EpiResidual{C.out, C.out, xb, C.in[I_BDOWN] + l * DM, ssq};
            }
            if (kind == 0) pg8::gemm_phase<pg8::EpiRowBf16, pg8::StaticOrder>(ring, xl, g, S, E0, C.tid);
            else if (kind == 1) pg8::gemm_phase<pg8::EpiSoftmax, pg8::StaticOrder>(ring, xl, g, S, E1, C.tid);
            else pg8::gemm_phase<pg8::EpiResidual, pg8::StaticOrder>(ring, xl, g, S, E2, C.tid);
        }
    }
}

extern "C" void kernel_launch(void* const* d_in, const int* in_sizes, int n_in, void* d_out, int out_size, void* d_ws, size_t ws_size, hipStream_t stream) {
    static int grid = 0;
    if (grid == 0) {
        if (n_in != N_IN || in_sizes[0] != TOK * DM || out_size != TOK * DM || ws_size < 256 * MiB) { fprintf(stderr, "kernel_launch: unexpected shapes (n_in %d, in0 %d, out %d, ws %zu)\n", n_in, n_in > 0 ? in_sizes[0] : -1, out_size, ws_size); grid = -1; return; }
        int dev = 0, cus = 0, per_cu = 0;
        if (hipGetDevice(&dev) != hipSuccess || hipDeviceGetAttribute(&cus, hipDeviceAttributeMultiprocessorCount, dev) != hipSuccess) { grid = -1; return; }
        if (hipFuncSetAttribute((const void*)enc_fwd, hipFuncAttributeMaxDynamicSharedMemorySize, LDS_BYTES) != hipSuccess) { fprintf(stderr, "kernel_launch: hipFuncSetAttribute failed\n"); grid = -1; return; }
        if (hipOccupancyMaxActiveBlocksPerMultiprocessor(&per_cu, (const void*)enc_fwd, 512, LDS_BYTES) != hipSuccess || per_cu < 1) fprintf(stderr, "kernel_launch: occupancy query says %d\n", per_cu);
        (void)hipGetLastError();
        grid = cus;
    }
    if (grid < 0) return;
    if (hipMemsetAsync((char*)d_ws + WS_CTL, 0, CTL_ZERO_BYTES, stream) != hipSuccess) return;
    Args a{};
    for (int i = 0; i < N_IN; ++i) a.in[i] = (const float*)d_in[i];
    a.out = (float*)d_out; a.ws = (unsigned char*)d_ws;
#if MK_PER_PHASE
    for (int ph = 0; ph < N_PHASES; ++ph) { a.ph_lo = ph; a.ph_hi = ph + 1; hipLaunchKernelGGL(enc_fwd, dim3(grid), dim3(512), LDS_BYTES, stream, a); }
#else
    a.ph_lo = 0; a.ph_hi = N_PHASES; hipLaunchKernelGGL(enc_fwd, dim3(grid), dim3(512), LDS_BYTES, stream, a);
#endif
}
```

```cpp
#include <hip/hip_runtime.h>
#include <cstdio>
#include <cstdint>

#ifndef PROBE_KIND
#define PROBE_KIND 0
#endif
#ifndef MK_PER_PHASE
#define MK_PER_PHASE 0
#endif

#define LAS __attribute__((address_space(3)))
#define GAS __attribute__((address_space(1)))
typedef unsigned short bf16;
typedef short bf16x8 __attribute__((ext_vector_type(8)));
typedef float f32x4 __attribute__((ext_vector_type(4)));
typedef float f32x2 __attribute__((ext_vector_type(2)));
typedef unsigned u32x4 __attribute__((ext_vector_type(4)));
typedef unsigned u32x2 __attribute__((ext_vector_type(2)));

constexpr int NBATCH = 4, SEQ = 4096, DM = 1024, TOK = NBATCH * SEQ;
constexpr int INW = 2176, INWP = 2304, OUTW = 768, DFF = 2816, DFF2 = 5632, MEML = 256, MEMR = NBATCH * MEML;
constexpr float EPS = 1e-6f;
constexpr float LOG2E = 1.4426950408889634f;
constexpr float QSCALE = 0.125f * LOG2E;

constexpr size_t MiB = 1u << 20;
constexpr size_t WS_CTL = 0, CTL_ZERO_BYTES = 1 * MiB;
constexpr size_t WS_SSQ = 1 * MiB;
constexpr size_t WS_TAB = 2 * MiB;
constexpr size_t WS_WSB = WS_TAB + 128 * 1024, WS_WPT = WS_TAB + 640 * 1024;
constexpr size_t WS_W = 3 * MiB;
constexpr size_t WL_WIN = 0, WL_WOUT = 4608 * 1024, WL_WUP = WL_WOUT + 1536 * 1024, WL_WDOWN = WL_WUP + 11 * MiB, WL_QKT = WL_WDOWN + 5632 * 1024, WL_VOT = WL_QKT + 8 * MiB, WL_STRIDE = WL_VOT + 8 * MiB;
static_assert(WL_STRIDE == 38 * MiB + 512 * 1024, "weights per layer");
constexpr size_t WS_XB = 80 * MiB;
constexpr size_t WS_TR = 112 * MiB;
constexpr size_t WS_Z = WS_TR, WS_Y = WS_TR + 72 * MiB;
constexpr size_t WS_P = WS_TR;
constexpr size_t WS_G = WS_TR, WS_UQ = WS_TR + 88 * MiB;
constexpr size_t WS_OG = WS_TR + 96 * MiB, WS_LSE = WS_TR + 104 * MiB;
constexpr size_t WS_WQ = WS_TR + 96 * MiB, WS_WKVT = WS_WQ + 4 * MiB, WS_WOT = WS_WKVT + 8 * MiB, WS_MEMN = WS_WOT + 4 * MiB, WS_KV = WS_MEMN + 2 * MiB, WS_END = WS_KV + 8 * MiB;
static_assert(WS_END <= 256 * MiB && WS_W + 2 * WL_STRIDE <= WS_XB && WS_UQ + (size_t)SEQ * DFF2 * 2 <= 256 * MiB, "ws map");

constexpr int RING_BYTES = 131072, XL_OFF = 131072, LDSCTL_OFF = 139264, MISC_OFF = LDSCTL_OFF + 320, LDS_BYTES = 147456;

namespace pg8 {
constexpr int BM = 256, BK = 64, HALF = 128, HTB = HALF * BK * 2, STAGE_BYTES = 8 * HTB, NXCD = 8, WGM = 8;
__host__ __device__ __forceinline__ int lds_byte(int r, int c) { const int st = (r >> 4) * 2 + (c >> 5), rr = r & 15, cc = c & 31, ob = rr * 64 + cc * 2; return st * 1024 + (ob ^ (((ob >> 9) & 1) << 5)); }
__host__ __device__ __forceinline__ void stage_rc(int b, int& R, int& C) { const int st = b / 1024, sb = b % 1024, swz = sb ^ (((sb >> 9) & 1) << 5); R = (st >> 1) * 16 + swz / 64; C = (st & 1) * 32 + (swz % 64) / 2; }
__host__ __device__ __forceinline__ int perm32(int rho) { const int n = rho >> 4, i = rho & 15; return 8 * (i >> 2) + 4 * n + (i & 3); }

struct Unit { int pm, pn; };
struct OpMap { int sh_m, mk_m, sh_n, mk_n; int c_mhi, c_mlo, c_nhi, c_nlo;
    __device__ __forceinline__ long long off(const Unit& u) const { return (long long)((u.pm >> sh_m) * c_mhi + (u.pm & mk_m) * c_mlo + (u.pn >> sh_n) * c_nhi + (u.pn & mk_n) * c_nlo); } };
struct Gemm { const bf16* A; const bf16* Bt; int K, lda, ldb; OpMap ma, mb; };
__device__ __forceinline__ OpMap map_rows(int ld) { OpMap m{0, 0, 0, 0, 0, 0, 0, 0}; m.c_mhi = 256 * ld; return m; }
__device__ __forceinline__ OpMap map_cols(int ld) { OpMap m{0, 0, 0, 0, 0, 0, 0, 0}; m.c_nhi = 256 * ld; return m; }

struct StaticOrder {
    int nM, nN, nwg, G, c;
    __device__ void init(int nM_, int nN_, int G_, int c_) { nM = nM_; nN = nN_; nwg = nM * nN; G = G_; c = c_; }
    __device__ bool next(int i, Unit& u) const {
        const long L = (long)i * G + c; if (L >= nwg) return false;
        int wgid = (int)L; { const int q = nwg / NXCD, r = nwg % NXCD, xcd = wgid % NXCD, off = wgid / NXCD; wgid = (xcd < r ? xcd * (q + 1) : r * (q + 1) + (xcd - r) * q) + off; }
        const int nig = WGM * nN, gid = wgid / nig, fm = gid * WGM, gsz = (nM - fm) < WGM ? (nM - fm) : WGM;
        u.pm = fm + ((wgid % nig) % gsz); u.pn = (wgid % nig) / gsz; return true;
    }
};

__device__ __forceinline__ unsigned cvt_pk_bf16(float lo, float hi) { unsigned r; asm volatile("v_cvt_pk_bf16_f32 %0, %1, %2" : "=v"(r) : "v"(lo), "v"(hi)); return r; }

__device__ __forceinline__ void rstd8(const float* ssq, int row0  , int fq, float (&rs)[2][4], float mul) {
    f32x4 p[2][4];
#pragma unroll
    for (int ai = 0; ai < 2; ++ai)
#pragma unroll
        for (int m = 0; m < 4; ++m) p[ai][m] = *(const GAS f32x4*)(ssq + (size_t)(row0 + ai * HALF + m * 16) * 16 + fq * 4);
#pragma unroll
    for (int ai = 0; ai < 2; ++ai)
#pragma unroll
        for (int m = 0; m < 4; ++m) { float s = (p[ai][m][0] + p[ai][m][1]) + (p[ai][m][2] + p[ai][m][3]); s += __shfl_xor(s, 16); s += __shfl_xor(s, 32);
            rs[ai][m] = mul / sqrtf(s * (1.0f / DM) + EPS); }
}
struct EpiRowBf16 {
    static constexpr bool PERM = true;
    bf16* O; int ldc; const float* bias; const float* ssq; int ssq_row_off; float cscale;
    __device__ __forceinline__ void operator()(f32x4 (&acc)[2][2][4][2], const Unit& u, int wr, int wc, int fr, int fq, LAS unsigned char*, int, int) const {
        const int rowt = u.pm * BM + wr * 64 + fr, col0 = u.pn * BM + wc * 32 + 8 * fq;
        float rs[2][4];
        if (ssq) rstd8(ssq, ssq_row_off + rowt, fq, rs, cscale);
        else {
#pragma unroll
            for (int ai = 0; ai < 2; ++ai)
#pragma unroll
                for (int m = 0; m < 4; ++m) rs[ai][m] = cscale; }
        f32x4 bv[2][2];
#pragma unroll
        for (int bj = 0; bj < 2; ++bj)
#pragma unroll
            for (int n = 0; n < 2; ++n) bv[bj][n] = bias ? *(const GAS f32x4*)(bias + col0 + bj * HALF + 4 * n) : (f32x4){0.f, 0.f, 0.f, 0.f};
#pragma unroll
        for (int ai = 0; ai < 2; ++ai)
#pragma unroll
            for (int m = 0; m < 4; ++m) { bf16* rowp = O + (size_t)(rowt + ai * HALF + m * 16) * ldc + col0; const float r = rs[ai][m];
#pragma unroll
                for (int bj = 0; bj < 2; ++bj) { const f32x4 v0 = acc[ai][bj][m][0] * r + bv[bj][0], v1 = acc[ai][bj][m][1] * r + bv[bj][1];
                    u32x4 w; w.x = cvt_pk_bf16(v0[0], v0[1]); w.y = cvt_pk_bf16(v0[2], v0[3]); w.z = cvt_pk_bf16(v1[0], v1[1]); w.w = cvt_pk_bf16(v1[2], v1[3]);
                    *(GAS u32x4*)(rowp + bj * HALF) = w; } }
    }
};
struct EpiSoftmax {
    static constexpr bool PERM = true;
    bf16* P; const float* ssq;
    __device__ __forceinline__ void operator()(f32x4 (&acc)[2][2][4][2], const Unit& u, int wr, int wc, int fr, int fq, LAS unsigned char* xl, int, int) const {
        const int rowt = u.pm * BM + wr * 64 + fr, col0 = u.pn * BM + wc * 32 + 8 * fq;
        LAS f32x2* X = (LAS f32x2*)xl;
        float ml[2][4], rs[2][4];
        rstd8(ssq, rowt, fq, rs, 1.0f);
#pragma unroll
        for (int ai = 0; ai < 2; ++ai)
#pragma unroll
            for (int m = 0; m < 4; ++m) {
                const float r = rs[ai][m];
                float mx = -3.0e38f;
#pragma unroll
                for (int bj = 0; bj < 2; ++bj)
#pragma unroll
                    for (int n = 0; n < 2; ++n) { f32x4 v = acc[ai][bj][m][n] * r; acc[ai][bj][m][n] = v; mx = fmaxf(fmaxf(fmaxf(v[0], v[1]), fmaxf(v[2], v[3])), mx); }
                mx = fmaxf(mx, __shfl_xor(mx, 16)); mx = fmaxf(mx, __shfl_xor(mx, 32));
                float l = 0.f;
#pragma unroll
                for (int bj = 0; bj < 2; ++bj)
#pragma unroll
                    for (int n = 0; n < 2; ++n) { f32x4 v = acc[ai][bj][m][n]; v[0] = __builtin_amdgcn_exp2f(v[0] - mx); v[1] = __builtin_amdgcn_exp2f(v[1] - mx); v[2] = __builtin_amdgcn_exp2f(v[2] - mx); v[3] = __builtin_amdgcn_exp2f(v[3] - mx);
                        acc[ai][bj][m][n] = v; l += (v[0] + v[1]) + (v[2] + v[3]); }
                l += __shfl_xor(l, 16); l += __shfl_xor(l, 32);
                ml[ai][m] = mx;
                if (fq == 0) X[(ai * HALF + wr * 64 + m * 16 + fr) * 4 + wc] = (f32x2){mx, l};
            }
        asm volatile("s_waitcnt lgkmcnt(0)" ::: "memory"); __builtin_amdgcn_s_barrier(); asm volatile("" ::: "memory");
#pragma unroll
        for (int ai = 0; ai < 2; ++ai)
#pragma unroll
            for (int m = 0; m < 4; ++m) {
                const LAS f32x2* xr = X + (ai * HALF + wr * 64 + m * 16 + fr) * 4;
                const f32x2 a = xr[0], b = xr[1], c = xr[2], d = xr[3];
                const float M = fmaxf(fmaxf(a.x, b.x), fmaxf(c.x, d.x));
                const float L = (a.y * __builtin_amdgcn_exp2f(a.x - M) + b.y * __builtin_amdgcn_exp2f(b.x - M)) + (c.y * __builtin_amdgcn_exp2f(c.x - M) + d.y * __builtin_amdgcn_exp2f(d.x - M));
                const float f = __builtin_amdgcn_exp2f(ml[ai][m] - M) / L;
                bf16* rowp = P + (size_t)(rowt + ai * HALF + m * 16) * DM + col0;
#pragma unroll
                for (int bj = 0; bj < 2; ++bj) { const f32x4 v0 = acc[ai][bj][m][0] * f, v1 = acc[ai][bj][m][1] * f;
                    u32x4 w; w.x = cvt_pk_bf16(v0[0], v0[1]); w.y = cvt_pk_bf16(v0[2], v0[3]); w.z = cvt_pk_bf16(v1[0], v1[1]); w.w = cvt_pk_bf16(v1[2], v1[3]);
                    *(GAS u32x4*)(rowp + bj * HALF) = w; }
            }
    }
};
struct EpiResidual {
    static constexpr bool PERM = false;
    const float* xold; float* xnew; bf16* xb; const float* bias; float* ssq;
    __device__ __forceinline__ void operator()(f32x4 (&acc)[2][2][4][2], const Unit& u, int wr, int wc, int fr, int fq, LAS unsigned char*, int, int) const {
        const int row0 = u.pm * BM + wr * 64 + fr, col0 = u.pn * BM + wc * 32 + 4 * fq;
        f32x4 bv[2][2];
#pragma unroll
        for (int bj = 0; bj < 2; ++bj)
#pragma unroll
            for (int n = 0; n < 2; ++n) bv[bj][n] = *(const GAS f32x4*)(bias + col0 + bj * HALF + n * 16);
#pragma unroll
        for (int ai = 0; ai < 2; ++ai)
#pragma unroll
            for (int m = 0; m < 4; ++m) { int row = row0 + ai * HALF + m * 16; asm volatile("" : "+v"(row)); const size_t off = (size_t)row * DM + col0; float sq = 0.f;
#pragma unroll
                for (int bj = 0; bj < 2; ++bj)
#pragma unroll
                    for (int n = 0; n < 2; ++n) { const f32x4 xo = *(const GAS f32x4*)(xold + off + bj * HALF + n * 16); const f32x4 v = (acc[ai][bj][m][n] + bv[bj][n]) + xo;
                        *(GAS f32x4*)(xnew + off + bj * HALF + n * 16) = v; sq += (v[0] * v[0] + v[1] * v[1]) + (v[2] * v[2] + v[3] * v[3]);
                        u32x2 w; w.x = cvt_pk_bf16(v[0], v[1]); w.y = cvt_pk_bf16(v[2], v[3]); *(GAS u32x2*)(xb + off + bj * HALF + n * 16) = w; }
                sq += __shfl_xor(sq, 16); sq += __shfl_xor(sq, 32);
                if (fq == 0) *(GAS float*)(ssq + (size_t)row * 16 + u.pn * 4 + wc) = sq;
                asm volatile("" ::: "memory"); }
    }
};

template <class Epi, class Sched>
__device__ __forceinline__ void gemm_phase(LAS unsigned char* lds, LAS unsigned char* xl, const Gemm g, const Sched& S, const Epi& E, const int tid) {
    const int wid = __builtin_amdgcn_readfirstlane(tid >> 6), lane = tid & 63, wr = wid >> 2, wc = wid & 3, fr = lane & 15, fq = lane >> 4;
    const int K = g.K, nt = K / BK;
    unsigned voffA[2], voffB[2];
#pragma unroll
    for (int i = 0; i < 2; ++i) { int R, C; stage_rc(tid * 16 + i * 8192, R, C); const int Rb = Epi::PERM ? ((R & ~31) + perm32(R & 31)) : R;
        voffA[i] = (unsigned)(R * g.lda + C) * 2u; voffB[i] = (unsigned)(Rb * g.ldb + C) * 2u; }
    const size_t kstep = (size_t)(BK * 2);
    const size_t hstepA = (size_t)HALF * g.lda * 2, hstepB = (size_t)HALF * g.ldb * 2;
    const unsigned ldsw = (unsigned)wid * 1024u;
    const int aoff = lds_byte(wr * 64 + fr, fq * 8), boff = lds_byte(wc * 32 + fr, fq * 8);
#define PG8_SA(b, h) (((b) * 2 + (h)) * HTB)
#define PG8_SB(b, h) ((4 + (b) * 2 + (h)) * HTB)
#define PG8_STAGE(bufoff, gbase, voff) do { _Pragma("unroll") for (int _i = 0; _i < 2; ++_i) \
        __builtin_amdgcn_global_load_lds((const unsigned*)((const char*)(gbase) + (voff)[_i]), (LAS unsigned*)(lds + (bufoff) + ldsw + _i * 8192), 16, 0, 0); } while (0)
#define PG8_LDA(dst, b, h) do { _Pragma("unroll") for (int m = 0; m < 4; ++m) _Pragma("unroll") for (int k = 0; k < 2; ++k) dst[m][k] = *(const LAS bf16x8*)(lds + PG8_SA(b, h) + aoff + m * 2048 + k * 1024); } while (0)
#define PG8_LDB(dst, b, h) do { _Pragma("unroll") for (int n = 0; n < 2; ++n) _Pragma("unroll") for (int k = 0; k < 2; ++k) dst[n][k] = *(const LAS bf16x8*)(lds + PG8_SB(b, h) + boff + n * 2048 + k * 1024); } while (0)
#define PG8_MMA(ai, bj, At, Bt) do { __builtin_amdgcn_s_setprio(1); _Pragma("unroll") for (int m = 0; m < 4; ++m) _Pragma("unroll") for (int n = 0; n < 2; ++n) _Pragma("unroll") for (int k = 0; k < 2; ++k) \
        acc[ai][bj][m][n] = __builtin_amdgcn_mfma_f32_16x16x32_bf16(Bt[n][k], At[m][k], acc[ai][bj][m][n], 0, 0, 0); __builtin_amdgcn_s_setprio(0); } while (0)
#define PG8_WAIT_V(n) asm volatile("s_waitcnt vmcnt(" #n ")" ::: "memory")
#define PG8_WAIT_L(n) asm volatile("s_waitcnt lgkmcnt(" #n ")" ::: "memory")
#define PG8_BAR __builtin_amdgcn_s_barrier()
#define PG8_SCHED __builtin_amdgcn_sched_barrier(0)
    Unit cur, nxt; int ui = 0;
    if (!S.next(0, cur)) return;
    f32x4 acc[2][2][4][2];
#pragma unroll
    for (int a = 0; a < 2; ++a)
#pragma unroll
        for (int b = 0; b < 2; ++b)
#pragma unroll
            for (int m = 0; m < 4; ++m)
#pragma unroll
                for (int n = 0; n < 2; ++n) acc[a][b][m][n] = (f32x4){0.f, 0.f, 0.f, 0.f};
    bf16x8 At[4][2], B0[2][2], B1[2][2];
    const char* cA = (const char*)(g.A + g.ma.off(cur)); const char* cB = (const char*)(g.Bt + g.mb.off(cur));
    PG8_STAGE(PG8_SB(0, 0), cB, voffB); PG8_STAGE(PG8_SB(0, 1), cB + hstepB, voffB); PG8_STAGE(PG8_SA(0, 0), cA, voffA); PG8_STAGE(PG8_SA(0, 1), cA + hstepA, voffA);
    if (wr == 1) PG8_BAR;
    PG8_WAIT_V(2); PG8_BAR;
    PG8_STAGE(PG8_SB(1, 0), cB + kstep, voffB); PG8_STAGE(PG8_SA(1, 0), cA + kstep, voffA); PG8_STAGE(PG8_SB(1, 1), cB + hstepB + kstep, voffB);
    PG8_WAIT_V(6); PG8_BAR;
    for (;;) {
        const bool has_next = S.next(ui + 1, nxt);
        const char* nA = has_next ? (const char*)(g.A + g.ma.off(nxt)) : cA; const char* nB = has_next ? (const char*)(g.Bt + g.mb.off(nxt)) : cB;
        for (int t = 0; t < nt; t += 2) {
            const bool last = (t == nt - 2);
            const char* a1 = cA + (size_t)(t + 1) * kstep;
            const char* a2 = last ? nA : cA + (size_t)(t + 2) * kstep; const char* b2 = last ? nB : cB + (size_t)(t + 2) * kstep;
            const char* a3 = a2 + kstep; const char* b3 = b2 + kstep;
            PG8_LDB(B0, 0, 0); PG8_LDB(B1, 0, 1); PG8_SCHED; PG8_LDA(At, 0, 0); PG8_STAGE(PG8_SA(1, 1), a1 + hstepA, voffA);
            PG8_WAIT_V(8); PG8_WAIT_L(0); PG8_BAR; PG8_MMA(0, 0, At, B0); PG8_MMA(0, 1, At, B1); PG8_BAR; PG8_SCHED;
            PG8_LDA(At, 0, 1); PG8_STAGE(PG8_SB(0, 0), b2, voffB); PG8_STAGE(PG8_SB(0, 1), b2 + hstepB, voffB); PG8_STAGE(PG8_SA(0, 0), a2, voffA);
            PG8_WAIT_V(8); PG8_WAIT_L(0); PG8_BAR; PG8_MMA(1, 0, At, B0); PG8_MMA(1, 1, At, B1); PG8_BAR; PG8_SCHED;
            PG8_LDB(B0, 1, 0); PG8_LDB(B1, 1, 1); PG8_SCHED; PG8_LDA(At, 1, 0); PG8_STAGE(PG8_SA(0, 1), a2 + hstepA, voffA);
            PG8_WAIT_V(8); PG8_WAIT_L(0); PG8_BAR; PG8_MMA(0, 0, At, B0); PG8_MMA(0, 1, At, B1); PG8_BAR; PG8_SCHED;
            PG8_LDA(At, 1, 1); PG8_STAGE(PG8_SB(1, 0), b3, voffB); PG8_STAGE(PG8_SB(1, 1), b3 + hstepB, voffB); PG8_STAGE(PG8_SA(1, 0), a3, voffA);
            PG8_WAIT_V(8); PG8_WAIT_L(0); PG8_BAR; PG8_MMA(1, 0, At, B0); PG8_MMA(1, 1, At, B1); PG8_BAR; PG8_SCHED;
        }
        if (wr == 0) PG8_BAR;
        { int fr_ = fr, fq_ = fq, lane_ = lane; asm volatile("" : "+v"(fr_), "+v"(fq_), "+v"(lane_));
          E(acc, cur, wr, wc, fr_, fq_, xl, wid, lane_); }
        if (!has_next) break;
#pragma unroll
        for (int a = 0; a < 2; ++a)
#pragma unroll
            for (int b = 0; b < 2; ++b)
#pragma unroll
                for (int m = 0; m < 4; ++m)
#pragma unroll
                    for (int n = 0; n < 2; ++n) acc[a][b][m][n] = (f32x4){0.f, 0.f, 0.f, 0.f};
        cur = nxt; cA = nA; cB = nB; ++ui;
        if (wr == 1) PG8_BAR;
    }
    PG8_WAIT_V(0);
    PG8_BAR;
#undef PG8_SA
#undef PG8_SB
#undef PG8_STAGE
#undef PG8_LDA
#undef PG8_LDB
#undef PG8_MMA
#undef PG8_WAIT_V
#undef PG8_WAIT_L
#undef PG8_BAR
#undef PG8_SCHED
}
}

typedef GAS unsigned gu32;
#define RLX_AGENT __ATOMIC_RELAXED, __HIP_MEMORY_SCOPE_AGENT
#define LDS_WAIT() asm volatile("s_waitcnt lgkmcnt(0)" ::: "memory")
#define VM_WAIT() asm volatile("s_waitcnt vmcnt(0)" ::: "memory")
__device__ __forceinline__ unsigned f2bf(float f) { unsigned u = __builtin_bit_cast(unsigned, f); return (u + 0x7fffu + ((u >> 16) & 1u)) >> 16; }
__device__ __forceinline__ unsigned pk2(float lo, float hi) { return f2bf(lo) | (f2bf(hi) << 16); }
__device__ __forceinline__ float bf2f(unsigned short h) { return __builtin_bit_cast(float, (unsigned)h << 16); }
__device__ __forceinline__ float bflo(unsigned w) { return __builtin_bit_cast(float, w << 16); }
__device__ __forceinline__ float bfhi(unsigned w) { return __builtin_bit_cast(float, w & 0xffff0000u); }
__device__ __forceinline__ float wave_sum(float v) {
#pragma unroll
    for (int o = 1; o < 64; o <<= 1) v += __shfl_xor(v, o);
    return v;
}
__device__ __forceinline__ float wave_max(float v) {
#pragma unroll
    for (int o = 1; o < 64; o <<= 1) v = fmaxf(v, __shfl_xor(v, o));
    return v;
}
__device__ __forceinline__ float gelu_tanh(float x) { const float u = 0.7978845608028654f * (x + 0.044715f * x * x * x); return x / (1.0f + __expf(-2.0f * u)); }
__device__ __forceinline__ float silu(float x) { return x / (1.0f + __expf(-x)); }

#define XB_TMO      128
#define XB_XCNT(j)  (256  + 64 * (j))
#define XB_XSUB(j)  (1280 + 64 * (j))
#define XB_XGEN(j)  (2304 + 64 * (j))
#define XB_TOP      3328
#define XB_TOPGEN   3392
#define XCD_BAR_WORDS 3456
#define XB_SPIN_CAP (1u << 18)
__device__ __forceinline__ unsigned xb_ld(unsigned* p)              { return __hip_atomic_load(p, __ATOMIC_RELAXED, __HIP_MEMORY_SCOPE_AGENT); }
__device__ __forceinline__ unsigned xb_add(unsigned* p, unsigned v) { return __hip_atomic_fetch_add(p, v, __ATOMIC_RELAXED, __HIP_MEMORY_SCOPE_AGENT); }
__device__ __forceinline__ unsigned xb_xcc_id() { return (unsigned)__builtin_amdgcn_s_getreg((3 << 11) | 20) & 0xFu; }
#define XB_SPIN(cond, bar) do { unsigned _sp = 0; while (cond) { __builtin_amdgcn_s_sleep(1); \
    if ((++_sp & 255u) == 0u) { if (xb_ld(&(bar)[XB_TMO])) break; if (_sp > XB_SPIN_CAP) { atomicAdd(&(bar)[XB_TMO], 1u); break; } } } } while (0)
struct XcdBarrier { unsigned* bar; unsigned x; volatile LAS unsigned* st; };
__device__ __forceinline__ XcdBarrier xcd_barrier_post(unsigned* bar, volatile LAS unsigned* st) {
    XcdBarrier b; b.bar = bar; b.x = xb_xcc_id(); b.st = st;
    if (threadIdx.x == 0) (void)xb_add(&bar[XB_XCNT(b.x)], 1u);
    return b;
}
__device__ __forceinline__ void xcd_barrier_complete(unsigned* bar, unsigned x, unsigned& nloc, unsigned& nx) {
    const unsigned G = gridDim.x * gridDim.y * gridDim.z;
    unsigned sum, cnt, mine, sp = 0u;
    for (;;) {
        sum = 0u; cnt = 0u; mine = 0u;
#pragma unroll
        for (unsigned j = 0; j < 16; ++j) { const unsigned c = xb_ld(&bar[XB_XCNT(j)]); sum += c; cnt += (c > 0u) ? 1u : 0u; mine = (j == x) ? c : mine; }
        if (sum == G) break;
        __builtin_amdgcn_s_sleep(1);
        if ((++sp & 255u) == 0u) { if (xb_ld(&bar[XB_TMO])) break; if (sp > XB_SPIN_CAP) { atomicAdd(&bar[XB_TMO], 1u); break; } }
    }
    nloc = mine > 0u ? mine : 1u; nx = cnt > 0u ? cnt : 1u;
}
__device__ __forceinline__ void xcd_barrier(const XcdBarrier& b) {
    asm volatile("s_waitcnt vmcnt(0)" ::: "memory");
    __syncthreads();
    if (threadIdx.x == 0) {
        unsigned* bar = b.bar;
        __builtin_amdgcn_s_waitcnt(0);
        unsigned nloc = b.st[0], nx = b.st[1];
        if (nloc == 0u) { xcd_barrier_complete(bar, b.x, nloc, nx); b.st[0] = nloc; b.st[1] = nx; }
        const unsigned old = xb_add(&bar[XB_XSUB(b.x)], 1u);
        const unsigned gen = old / nloc;
        if (old + 1u == (gen + 1u) * nloc) {
            __builtin_amdgcn_fence(__ATOMIC_RELEASE, "agent");
            asm volatile("s_waitcnt vmcnt(0)" ::: "memory");
            const unsigned og = xb_add(&bar[XB_TOP], 1u);
            const unsigned tg = og / nx;
            if (og + 1u == (tg + 1u) * nx) xb_add(&bar[XB_TOPGEN], 1u);
            else XB_SPIN(xb_ld(&bar[XB_TOPGEN]) == tg, bar);
            __builtin_amdgcn_fence(__ATOMIC_ACQUIRE, "agent");
            xb_add(&bar[XB_XGEN(b.x)], 1u);
            asm volatile("s_waitcnt vmcnt(0)" ::: "memory");
        } else {
            XB_SPIN(xb_ld(&bar[XB_XGEN(b.x)]) == gen, bar);
            __builtin_amdgcn_fence(__ATOMIC_ACQUIRE, "agent");
            asm volatile("s_waitcnt vmcnt(0)" ::: "memory");
        }
    }
    __syncthreads();
}

enum { I_X = 0, I_MEM, I_REL, I_MEMG, I_NMIXG, I_WIN, I_BIN, I_VG, I_WS, I_BS, I_PW, I_PB, I_PSC, I_WOUT, I_BOUT, I_NMEMG, I_WQ, I_WKV, I_WO, I_BO, I_NFFNG, I_WUP, I_BUP, I_CW, I_CB, I_WDOWN, I_BDOWN, I_FNG, N_IN };
struct Args { const float* in[N_IN]; float* out; unsigned char* ws; int ph_lo, ph_hi; };
constexpr int PH_PRO = 0, PH_KV = 1, PH_QV = 2, PH_L0 = 3, PH_PER_LAYER = 15, PH_FINAL = PH_L0 + 2 * PH_PER_LAYER, N_PHASES = PH_FINAL + 1;

struct Ctx {
    LAS unsigned char* lds; int tid, lane, wave, G, bid;
    const float* const* in; float* out; unsigned char* ws;
    __device__ __forceinline__ bf16* wl(int l, size_t off) const { return (bf16*)(ws + WS_W + (size_t)l * WL_STRIDE + off); }
};

__device__ __forceinline__ void tr_item(const float* W, int ldw, const float* gain, bf16* WT, int K, int k0, int n0, int drow0, LAS float* scr, int lane, float cs = 1.0f) {
#pragma unroll 8
    for (int i = 0; i < 32; ++i) { const int kk = 2 * i + (lane >> 5); float v = W[(size_t)(k0 + kk) * ldw + n0 + (lane & 31)] * cs; if (gain) v *= gain[k0 + kk]; scr[kk * 33 + (lane & 31)] = v; }
    LDS_WAIT(); asm volatile("" ::: "memory");
    const int c = lane & 7;
#pragma unroll
    for (int j = 0; j < 4; ++j) { const int n = (lane >> 3) + 8 * j; const LAS float* s = scr + (8 * c) * 33 + n;
        u32x4 o; o.x = pk2(s[0 * 33], s[1 * 33]); o.y = pk2(s[2 * 33], s[3 * 33]); o.z = pk2(s[4 * 33], s[5 * 33]); o.w = pk2(s[6 * 33], s[7 * 33]);
        *(u32x4*)(WT + (size_t)(drow0 + n) * K + k0 + 8 * c) = o; }
    LDS_WAIT(); asm volatile("" ::: "memory");
}
__device__ __forceinline__ void phase_prologue(const Ctx& C) {
    LAS float* scr = (LAS float*)(C.lds + C.wave * 16384);
    const int gw = C.bid * 8 + C.wave, NGW = C.G * 8, lane = C.lane;
    constexpr int I_IN = 16 * 68, I_OUT = 12 * 32, I_KV = 16 * 64, I_O = 16 * 32, I_UP = 16 * 176, I_DN = 44 * 32, I_L = I_IN + I_OUT + I_KV + I_O + I_UP + I_DN;
    for (int it = gw; it < 2 * I_L; it += NGW) {
        const int l = it / I_L; int r = it % I_L;
        if (r < I_IN) { const int kb = r / 68, nb = r % 68; tr_item(C.in[I_WIN] + (size_t)l * DM * INW, INW, C.in[I_NMIXG] + l * DM, C.wl(l, WL_WIN), DM, kb * 64, nb * 32, nb * 32, scr, lane, (nb * 32 >= 1024 && nb * 32 < 1408) ? QSCALE : 1.0f); continue; } r -= I_IN;
        if (r < I_OUT) { const int kb = r / 32, nb = r % 32; tr_item(C.in[I_WOUT] + (size_t)l * OUTW * DM, DM, nullptr, C.wl(l, WL_WOUT), OUTW, kb * 64, nb * 32, nb * 32, scr, lane); continue; } r -= I_OUT;
        if (r < I_KV) { const int kb = r / 64, nb = r % 64; tr_item(C.in[I_WKV] + (size_t)l * DM * 2048, 2048, nullptr, (bf16*)(C.ws + WS_WKVT) + (size_t)l * 2048 * DM, DM, kb * 64, nb * 32, nb * 32, scr, lane); continue; } r -= I_KV;
        if (r < I_O) { const int kb = r / 32, nb = r % 32; tr_item(C.in[I_WO] + (size_t)l * DM * DM, DM, nullptr, (bf16*)(C.ws + WS_WOT) + (size_t)l * DM * DM, DM, kb * 64, nb * 32, nb * 32, scr, lane); continue; } r -= I_O;
        if (r < I_UP) { const int kb = r / 176, nb = r % 176; const int n0 = nb * 32; const int drow = n0 < DFF ? (n0 / 128) * 256 + (n0 % 128) : ((n0 - DFF) / 128) * 256 + 128 + ((n0 - DFF) % 128);
            tr_item(C.in[I_WUP] + (size_t)l * DM * DFF2, DFF2, C.in[I_NFFNG] + l * DM, C.wl(l, WL_WUP), DM, kb * 64, n0, drow, scr, lane); continue; } r -= I_UP;
        { const int kb = r / 32, nb = r % 32; tr_item(C.in[I_WDOWN] + (size_t)l * DFF * DM, DM, nullptr, C.wl(l, WL_WDOWN), DFF, kb * 64, nb * 32, nb * 32, scr, lane); }
    }
    for (int i = gw * 64 + lane; i < 2 * (INWP - INW) * DM / 8; i += NGW * 64) { const int l = i / ((INWP - INW) * DM / 8), j = i % ((INWP - INW) * DM / 8);
        unsigned z0 = 0u; asm volatile("" : "+v"(z0)); *((u32x4*)(C.wl(l, WL_WIN) + (size_t)INW * DM) + j) = (u32x4){z0, z0, z0, z0}; }
    for (int r = gw; r < 2 * DM; r += NGW) { const int l = r / DM, k = r % DM; const float gk = C.in[I_NMEMG][l * DM + k];
        const f32x4* src = (const f32x4*)(C.in[I_WQ] + (size_t)l * DM * DM + (size_t)k * DM); u32x2* dst = (u32x2*)((bf16*)(C.ws + WS_WQ) + (size_t)l * DM * DM + (size_t)k * DM);
#pragma unroll
        for (int j = 0; j < 4; ++j) { const f32x4 v = src[lane + 64 * j] * gk; u32x2 w; w.x = pk2(v[0], v[1]); w.y = pk2(v[2], v[3]); dst[lane + 64 * j] = w; } }
    for (int r = gw; r < TOK; r += NGW) { const f32x4* src = (const f32x4*)(C.in[I_X] + (size_t)r * DM); u32x2* dst = (u32x2*)((bf16*)(C.ws + WS_XB) + (size_t)r * DM); float s = 0.f;
#pragma unroll
        for (int j = 0; j < 4; ++j) { const f32x4 v = src[lane + 64 * j]; s += (v[0] * v[0] + v[1] * v[1]) + (v[2] * v[2] + v[3] * v[3]); u32x2 w; w.x = pk2(v[0], v[1]); w.y = pk2(v[2], v[3]); dst[lane + 64 * j] = w; }
        s = wave_sum(s); if (lane < 16) ((float*)(C.ws + WS_SSQ))[(size_t)r * 16 + lane] = lane == 0 ? s : 0.f; }
    for (int r = gw; r < MEMR; r += NGW) { const f32x4* src = (const f32x4*)(C.in[I_MEM] + (size_t)r * DM); const f32x4* gg = (const f32x4*)C.in[I_MEMG]; u32x2* dst = (u32x2*)((bf16*)(C.ws + WS_MEMN) + (size_t)r * DM);
        f32x4 v[4]; float s = 0.f;
#pragma unroll
        for (int j = 0; j < 4; ++j) { v[j] = src[lane + 64 * j]; s += (v[j][0] * v[j][0] + v[j][1] * v[j][1]) + (v[j][2] * v[j][2] + v[j][3] * v[j][3]); }
        const float rs = 1.0f / sqrtf(wave_sum(s) * (1.0f / DM) + EPS);
#pragma unroll
        for (int j = 0; j < 4; ++j) { const f32x4 o = v[j] * rs * gg[lane + 64 * j]; u32x2 w; w.x = pk2(o[0], o[1]); w.y = pk2(o[2], o[3]); dst[lane + 64 * j] = w; } }
    for (int i = C.bid * 512 + C.tid; i < 2 * 6 * 128 * 128; i += C.G * 512) ((bf16*)(C.ws + WS_WSB))[i] = (bf16)f2bf(C.in[I_WS][i]);
    for (int i = C.bid * 512 + C.tid; i < 2 * 4 * 64 * 64; i += C.G * 512) { const int lg = i >> 12, f = (i >> 6) & 63, e = i & 63; ((bf16*)(C.ws + WS_WPT))[i] = (bf16)f2bf(C.in[I_PW][(lg * 64 + e) * 64 + f]); }
    float* tab = (float*)(C.ws + WS_TAB);
    for (int i = C.bid * 512 + C.tid; i < 2 * INWP; i += C.G * 512) { const int l = i / INWP, c = i % INWP; tab[i] = c < INW ? C.in[I_BIN][l * INW + c] * ((c >= 1024 && c < 1408) ? QSCALE : 1.0f) : 0.f; }
    for (int i = C.bid * 512 + C.tid; i < 2 * DFF2; i += C.G * 512) { const int l = i / DFF2, c = i % DFF2; const int t = c >> 8, w = c & 255; const int src = w < 128 ? t * 128 + w : DFF + t * 128 + (w - 128);
        tab[2 * INWP + i] = C.in[I_BUP][l * DFF2 + src]; }
}

__device__ __forceinline__ int t5_bucket(int rel) {
    const int n = rel < 0 ? -rel : rel; int b = rel > 0 ? 16 : 0;
    if (n < 8) return b + n;
    return b + 8 + (n >= 15) + (n >= 27) + (n >= 50) + (n >= 91) + (n >= 166) + (n >= 305) + (n >= 559);
}
namespace att {
typedef float f32x16 __attribute__((ext_vector_type(16)));
typedef short s16x4 __attribute__((ext_vector_type(4)));
typedef __bf16 bf16x2_t __attribute__((ext_vector_type(2)));
__device__ __forceinline__ unsigned cvtpk(float lo, float hi) { f32x2 v = {lo, hi}; bf16x2_t b = __builtin_convertvector(v, bf16x2_t); return __builtin_bit_cast(unsigned, b); }
__device__ __forceinline__ s16x4 vtr(const LAS unsigned char* p) { return __builtin_bit_cast(s16x4, __builtin_amdgcn_ds_read_tr16_b64_v4i16((LAS s16x4*)p)); }
constexpr int OFF_K = 0, OFF_V = 49152, OFF_WS = 98304, OFF_TAB = 102400;
template <bool MERGE>
__device__ __forceinline__ void unit(const Ctx& C, int g, int b, int h, int r, int blk) {
    const int tid = C.tid, lane = C.lane, wid = C.wave, r32 = lane & 31, hi = lane >> 5;
    const int d = 1 << (2 * g), L = SEQ >> (2 * g), q0 = blk * 256;
    const bf16* z = (const bf16*)(C.ws + WS_Z);
    const bf16* zb = z + ((size_t)b * SEQ + r) * INWP; const size_t rp = (size_t)d * INWP;
    const int colq = 1024 + g * 128 + h * 64, colk = 1408 + g * 128 + h * 64, colv = 1792 + g * 128 + h * 64;
    LAS unsigned char* lds = C.lds;
    LAS float* tabL = (LAS float*)(lds + OFF_TAB);
    if (tid < 255) { const int dl = tid - 127; float v = -3.0e38f; if (dl >= -64 && dl <= 64) v = C.in[I_REL][t5_bucket(dl * d) * 6 + g * 2 + h] * LOG2E; tabL[tid] = v; }
#pragma unroll
    for (int t = 0; t < 6; ++t) {
        int ki = q0 - 64 + 64 * t + lane; ki = ki < 0 ? 0 : (ki >= L ? L - 1 : ki);
        __builtin_amdgcn_global_load_lds((const unsigned*)(zb + (size_t)ki * rp + colk + wid * 8), (LAS unsigned*)(lds + OFF_K + t * 8192 + wid * 1024), 16, 0, 0);
        int vi = q0 - 64 + 64 * t + 16 * (wid & 3) + (lane >> 2); vi = vi < 0 ? 0 : (vi >= L ? L - 1 : vi);
        __builtin_amdgcn_global_load_lds((const unsigned*)(zb + (size_t)vi * rp + colv + (wid >> 2) * 32 + (lane & 3) * 8), (LAS unsigned*)(lds + OFF_V + t * 8192 + wid * 1024), 16, 0, 0);
    }
    bf16x8 qr[4];
    { const bf16* qp = zb + (size_t)(q0 + 32 * wid + r32) * rp + colq + hi * 8;
#pragma unroll
      for (int d0 = 0; d0 < 4; ++d0) qr[d0] = *(const GAS bf16x8*)(qp + d0 * 16); }
    asm volatile("s_waitcnt vmcnt(0)" ::: "memory"); __syncthreads();
    const int tb = wid >> 1;
    f32x16 S[3][2];
#pragma unroll
    for (int tt = 0; tt < 3; ++tt) {
        const LAS unsigned char* Ks = lds + OFF_K + (tb + tt) * 8192 + hi * 1024 + r32 * 16;
#pragma unroll
        for (int p = 0; p < 2; ++p)
#pragma unroll
            for (int i = 0; i < 16; ++i) S[tt][p][i] = 0.f;
#pragma unroll
        for (int d0 = 0; d0 < 4; ++d0) { const bf16x8 k0 = *(const LAS bf16x8*)(Ks + d0 * 2048), k1 = *(const LAS bf16x8*)(Ks + d0 * 2048 + 512);
            S[tt][0] = __builtin_amdgcn_mfma_f32_32x32x16_bf16(k0, qr[d0], S[tt][0], 0, 0, 0); S[tt][1] = __builtin_amdgcn_mfma_f32_32x32x16_bf16(k1, qr[d0], S[tt][1], 0, 0, 0); }
    }
    { const LAS float* tp = tabL + (4 * hi - r32 - 32 * (wid & 1) + 63);
      const bool edge = (blk == 0) || (q0 + 256 >= L); const int kb = q0 - 64 + 64 * tb + 4 * hi;
      float mx = -3.0e38f;
#pragma unroll
      for (int tt = 0; tt < 3; ++tt)
#pragma unroll
          for (int p = 0; p < 2; ++p)
#pragma unroll
              for (int i = 0; i < 16; ++i) { const int cr = 64 * tt + 32 * p + (i & 3) + 8 * (i >> 2); float v = S[tt][p][i] + tp[cr];
                  if (edge) { const int kidx = kb + cr; if (kidx < 0 || kidx >= L) v = -3.0e38f; }
                  S[tt][p][i] = v; mx = fmaxf(mx, v); }
      mx = fmaxf(mx, __shfl_xor(mx, 32));
      float l = 0.f;
#pragma unroll
      for (int tt = 0; tt < 3; ++tt)
#pragma unroll
          for (int p = 0; p < 2; ++p)
#pragma unroll
              for (int i = 0; i < 16; ++i) { const float e = __builtin_amdgcn_exp2f(S[tt][p][i] - mx); S[tt][p][i] = e; l += e; }
      l += __shfl_xor(l, 32);
      LAS float* wsf = (LAS float*)(lds + OFF_WS) + wid * 128;
      const int tokq = b * SEQ + r + d * (q0 + 32 * wid + r32);
      if (!MERGE) { if (hi == 0) { wsf[r32] = 1.0f / l; ((float*)(C.ws + WS_LSE))[((size_t)(g - 1) * TOK + tokq) * 2 + h] = mx + __builtin_amdgcn_logf(l); } }
      else if (hi == 0) { const float* lse = (const float*)(C.ws + WS_LSE); const float l0 = mx + __builtin_amdgcn_logf(l), l1 = lse[(size_t)tokq * 2 + h], l2 = lse[((size_t)TOK + tokq) * 2 + h];
          const float M = fmaxf(fmaxf(l0, l1), l2); const float w0 = __builtin_amdgcn_exp2f(l0 - M), w1 = __builtin_amdgcn_exp2f(l1 - M), w2 = __builtin_amdgcn_exp2f(l2 - M); const float iw = 1.0f / (w0 + w1 + w2);
          wsf[r32] = w0 * iw / l; wsf[32 + r32] = w1 * iw; wsf[64 + r32] = w2 * iw; }
    }
    f32x16 o[2];
#pragma unroll
    for (int i = 0; i < 16; ++i) { o[0][i] = 0.f; o[1][i] = 0.f; }
    { const LAS unsigned char* vp0 = lds + OFF_V + ((lane >> 4) & 1) * 32 + (lane & 3) * 8 + (4 * hi + ((lane & 15) >> 2)) * 64;
#pragma unroll
      for (int tt = 0; tt < 3; ++tt) { const LAS unsigned char* vt = vp0 + (tb + tt) * 8192;
#pragma unroll
          for (int ks = 0; ks < 4; ++ks) { const f32x16& P = S[tt][ks >> 1]; const int rb = (ks & 1) * 8;
              u32x4 pw; pw.x = cvtpk(P[rb + 0], P[rb + 1]); pw.y = cvtpk(P[rb + 2], P[rb + 3]); pw.z = cvtpk(P[rb + 4], P[rb + 5]); pw.w = cvtpk(P[rb + 6], P[rb + 7]);
              const bf16x8 pa = __builtin_bit_cast(bf16x8, pw);
#pragma unroll
              for (int dh = 0; dh < 2; ++dh) { const s16x4 lo = vtr(vt + dh * 4096 + ks * 1024), hi4 = vtr(vt + dh * 4096 + ks * 1024 + 512);
                  const bf16x8 vf = (bf16x8){lo[0], lo[1], lo[2], lo[3], hi4[0], hi4[1], hi4[2], hi4[3]};
                  o[dh] = __builtin_amdgcn_mfma_f32_32x32x16_bf16(pa, vf, o[dh], 0, 0, 0); } } }
    }
    asm volatile("s_waitcnt lgkmcnt(0)" ::: "memory"); __syncthreads();
    { LAS float* stg = (LAS float*)(lds + wid * 8192); const LAS float* wsf = (const LAS float*)(lds + OFF_WS) + wid * 128;
#pragma unroll
      for (int i = 0; i < 16; ++i) { const int q = (i & 3) + 8 * (i >> 2) + 4 * hi; stg[q * 64 + r32] = o[0][i]; stg[q * 64 + 32 + r32] = o[1][i]; }
      asm volatile("s_waitcnt lgkmcnt(0)" ::: "memory");
#pragma unroll
      for (int it = 0; it < 4; ++it) { const int row = it * 8 + (lane >> 3), ch = lane & 7; const size_t tok = (size_t)b * SEQ + r + (size_t)d * (q0 + 32 * wid + row);
          const f32x4 a0 = *(const LAS f32x4*)(stg + row * 64 + ch * 8), a1 = *(const LAS f32x4*)(stg + row * 64 + ch * 8 + 4); const float c0 = wsf[row];
          float v[8] = {a0[0] * c0, a0[1] * c0, a0[2] * c0, a0[3] * c0, a1[0] * c0, a1[1] * c0, a1[2] * c0, a1[3] * c0};
          if (MERGE) { const bf16* og = (const bf16*)(C.ws + WS_OG); const float c1 = wsf[32 + row], c2 = wsf[64 + row];
              const u32x4 x1 = *(const GAS u32x4*)(og + tok * 128 + h * 64 + ch * 8), x2 = *(const GAS u32x4*)(og + ((size_t)TOK + tok) * 128 + h * 64 + ch * 8);
#pragma unroll
              for (int e = 0; e < 4; ++e) { v[2 * e] += c1 * bflo(x1[e]) + c2 * bflo(x2[e]); v[2 * e + 1] += c1 * bfhi(x1[e]) + c2 * bfhi(x2[e]); } }
          u32x4 w; w.x = cvtpk(v[0], v[1]); w.y = cvtpk(v[2], v[3]); w.z = cvtpk(v[4], v[5]); w.w = cvtpk(v[6], v[7]);
          if (MERGE) *(GAS u32x4*)((bf16*)(C.ws + WS_Y) + tok * OUTW + 640 + h * 64 + ch * 8) = w;
          else *(GAS u32x4*)((bf16*)(C.ws + WS_OG) + ((size_t)(g - 1) * TOK + tok) * 128 + h * 64 + ch * 8) = w; }
    }
    asm volatile("s_waitcnt lgkmcnt(0)" ::: "memory"); __syncthreads();
}
}
__device__ __forceinline__ void phase_attn12(const Ctx& C) {
    for (int u = C.bid; u < 256; u += C.G) {
        if (u < 128) att::unit<false>(C, 1, u >> 5, (u >> 4) & 1, (u >> 2) & 3, u & 3);
        else { const int v = u - 128; att::unit<false>(C, 2, v >> 5, (v >> 4) & 1, v & 15, 0); }
    }
}

__device__ __forceinline__ void unpack8(const u32x4 v, float (&f)[8]) {
#pragma unroll
    for (int e = 0; e < 4; ++e) { f[2 * e] = bflo(v[e]); f[2 * e + 1] = bfhi(v[e]); }
}
__device__ __forceinline__ void gmlp_unit(const Ctx& C, int l, int b, int n, int h) {
    const int tid = C.tid, lane = C.lane, wid = C.wave, fr = lane & 15, fq = lane >> 4;
    const bf16* z = (const bf16*)(C.ws + WS_Z); bf16* y = (bf16*)(C.ws + WS_Y);
    const size_t r0 = (size_t)b * SEQ + n * 128;
    LAS bf16* vnT = (LAS bf16*)C.lds;
    { const int q = tid >> 2, part = tid & 3; const bf16* src = z + (r0 + q) * INWP + 384 + h * 64 + part * 16;
      const u32x4 a = *(const GAS u32x4*)src, bq = *(const GAS u32x4*)(src + 8);
      float v[16]; { float t0[8], t1[8]; unpack8(a, t0); unpack8(bq, t1);
#pragma unroll
          for (int j = 0; j < 8; ++j) { v[j] = gelu_tanh(t0[j]); v[8 + j] = gelu_tanh(t1[j]); } }
      float ss = 0.f;
#pragma unroll
      for (int j = 0; j < 16; ++j) ss += v[j] * v[j];
      ss += __shfl_xor(ss, 1); ss += __shfl_xor(ss, 2);
      const float rs = 1.0f / sqrtf(ss * (1.0f / 64) + EPS);
      const float* vg = C.in[I_VG] + (l * 6 + h) * 64 + part * 16;
#pragma unroll
      for (int j = 0; j < 16; ++j) vnT[(part * 16 + j) * 136 + q] = (bf16)f2bf(v[j] * rs * vg[j]); }
    asm volatile("s_waitcnt lgkmcnt(0)" ::: "memory"); __syncthreads();
    const bf16* wsb = (const bf16*)(C.ws + WS_WSB) + ((size_t)(l * 6 + h) * 128 + 16 * wid + fr) * 128 + fq * 8;
    bf16x8 bfr[4];
#pragma unroll
    for (int ks = 0; ks < 4; ++ks) bfr[ks] = *(const GAS bf16x8*)(wsb + ks * 32);
    f32x4 acc[4];
#pragma unroll
    for (int m = 0; m < 4; ++m) { acc[m] = (f32x4){0.f, 0.f, 0.f, 0.f};
#pragma unroll
        for (int ks = 0; ks < 4; ++ks) { const bf16x8 af = *(const LAS bf16x8*)(vnT + (16 * m + fr) * 136 + ks * 32 + fq * 8); acc[m] = __builtin_amdgcn_mfma_f32_16x16x32_bf16(af, bfr[ks], acc[m], 0, 0, 0); } }
    const int p = 16 * wid + fr; const float bsv = C.in[I_BS][(l * 6 + h) * 128 + p];
#pragma unroll
    for (int m = 0; m < 4; ++m) { const int e0 = 16 * m + 4 * fq; const u32x2 zu = *(const GAS u32x2*)(z + (r0 + p) * INWP + h * 64 + e0);
        const float u0 = gelu_tanh(bflo(zu.x)), u1 = gelu_tanh(bfhi(zu.x)), u2 = gelu_tanh(bflo(zu.y)), u3 = gelu_tanh(bfhi(zu.y));
        u32x2 w; w.x = pk2(u0 * (acc[m][0] + bsv), u1 * (acc[m][1] + bsv)); w.y = pk2(u2 * (acc[m][2] + bsv), u3 * (acc[m][3] + bsv));
        *(GAS u32x2*)(y + (r0 + p) * OUTW + h * 64 + e0) = w; }
    __syncthreads();
}
__device__ __forceinline__ void pool_unit(const Ctx& C, int l, int uu) {
    const int tid = C.tid, lane = C.lane, wid = C.wave, fr = lane & 15, fq = lane >> 4;
    const bf16* z = (const bf16*)(C.ws + WS_Z); bf16* y = (bf16*)(C.ws + WS_Y);
    const int r0 = uu * 64, pos0 = r0 & (SEQ - 1), base = r0 - pos0;
    LAS unsigned char* zt = C.lds + 32768;
    LAS unsigned char* pl = zt + 43008;
    for (int i = tid; i < 80 * 32; i += 512) { const int rr = i >> 5, c = i & 31, pos = pos0 - 8 + rr; unsigned z0 = 0u; asm volatile("" : "+v"(z0)); u32x4 v = (u32x4){z0, z0, z0, z0};
        if (pos >= 0 && pos < SEQ) v = *(const GAS u32x4*)(z + (size_t)(base + pos) * INWP + 768 + c * 8);
        *(LAS u32x4*)(zt + rr * 528 + c * 16) = v; }
    asm volatile("s_waitcnt lgkmcnt(0)" ::: "memory"); __syncthreads();
    for (int i = tid; i < 64 * 32; i += 512) { const int t = i >> 5, c = i & 31, g = c >> 3, hw = 1 << g, pos = pos0 + t;
        const int lo = pos - hw < 0 ? 0 : pos - hw, hi = pos + hw > SEQ ? SEQ : pos + hw;
        float sacc[8];
#pragma unroll
        for (int e = 0; e < 8; ++e) sacc[e] = 0.f;
        for (int p = lo; p < hi; ++p) { float f[8]; unpack8(*(const LAS u32x4*)(zt + (p - pos0 + 8) * 528 + c * 16), f);
#pragma unroll
            for (int e = 0; e < 8; ++e) sacc[e] += f[e]; }
        float own[8]; unpack8(*(const LAS u32x4*)(zt + (t + 8) * 528 + c * 16), own); const float inv = 1.0f / (float)(hi - lo);
        u32x4 w; w.x = pk2(sacc[0] * inv - own[0], sacc[1] * inv - own[1]); w.y = pk2(sacc[2] * inv - own[2], sacc[3] * inv - own[3]);
        w.z = pk2(sacc[4] * inv - own[4], sacc[5] * inv - own[5]); w.w = pk2(sacc[6] * inv - own[6], sacc[7] * inv - own[7]);
        *(LAS u32x4*)(pl + t * 528 + c * 16) = w; }
    asm volatile("s_waitcnt lgkmcnt(0)" ::: "memory"); __syncthreads();
    const int g = wid >> 1; const bf16* wpt = (const bf16*)(C.ws + WS_WPT) + (size_t)(l * 4 + g) * 4096;
    bf16x8 af[4][2];
#pragma unroll
    for (int m = 0; m < 4; ++m)
#pragma unroll
        for (int ks = 0; ks < 2; ++ks) af[m][ks] = *(const GAS bf16x8*)(wpt + (16 * m + fr) * 64 + ks * 32 + fq * 8);
    const float* pb = C.in[I_PB] + l * 256 + g * 64; const float* psc = C.in[I_PSC] + l * 256 + g * 64;
#pragma unroll
    for (int nt = 0; nt < 2; ++nt) { const int tN = ((wid & 1) * 2 + nt) * 16;
        f32x4 acc[4];
#pragma unroll
        for (int m = 0; m < 4; ++m) acc[m] = (f32x4){0.f, 0.f, 0.f, 0.f};
#pragma unroll
        for (int ks = 0; ks < 2; ++ks) { const bf16x8 bfg = *(const LAS bf16x8*)(pl + (tN + fr) * 528 + (g * 64 + ks * 32 + fq * 8) * 2);
#pragma unroll
            for (int m = 0; m < 4; ++m) acc[m] = __builtin_amdgcn_mfma_f32_16x16x32_bf16(af[m][ks], bfg, acc[m], 0, 0, 0); }
#pragma unroll
        for (int m = 0; m < 4; ++m) { const int f0 = 16 * m + 4 * fq; const f32x4 bb = *(const GAS f32x4*)(pb + f0), sc = *(const GAS f32x4*)(psc + f0); const f32x4 o = (acc[m] + bb) * sc;
            u32x2 w; w.x = pk2(o[0], o[1]); w.y = pk2(o[2], o[3]); *(GAS u32x2*)(y + (size_t)(r0 + tN + fr) * OUTW + 384 + g * 64 + f0) = w; } }
    __syncthreads();
}
__device__ __forceinline__ void phase_mixer(const Ctx& C, int l) {
    for (int uu = C.bid; uu < NBATCH * 32 * 6; uu += C.G) gmlp_unit(C, l, uu / 192, (uu / 6) % 32, uu % 6);
    for (int uu = C.bid; uu < TOK / 64; uu += C.G) pool_unit(C, l, uu);
    for (int u = C.bid; u < 128; u += C.G) att::unit<true>(C, 0, u >> 5, (u >> 4) & 1, 0, u & 15);
}

__device__ __forceinline__ void phase_conv(const Ctx& C, int l, int qd) {
    const bf16* uq = (const bf16*)(C.ws + WS_UQ); bf16* gout = (bf16*)(C.ws + WS_G) + (size_t)qd * SEQ * DFF;
    const float* cw = C.in[I_CW] + (size_t)l * 3 * DFF2; const float* cb = C.in[I_CB] + (size_t)l * DFF2;
    const int NI = SEQ * (DFF / 8);
    for (int i = C.bid * 512 + C.tid; i < NI; i += C.G * 512) {
        const int row = i / (DFF / 8), c8 = (i % (DFF / 8)) * 8; const int t = c8 >> 7, w = c8 & 127;
        const bf16* pg = uq + (size_t)row * DFF2 + t * 256 + w; const bf16* pv = pg + 128;
        unsigned z0 = 0u; asm volatile("" : "+v"(z0)); const u32x4 zero = (u32x4){z0, z0, z0, z0};
        const u32x4 g0 = row > 0 ? *(const u32x4*)(pg - DFF2) : zero, g1 = *(const u32x4*)pg, g2 = row < SEQ - 1 ? *(const u32x4*)(pg + DFF2) : zero;
        const u32x4 v0 = row > 0 ? *(const u32x4*)(pv - DFF2) : zero, v1 = *(const u32x4*)pv, v2 = row < SEQ - 1 ? *(const u32x4*)(pv + DFF2) : zero;
        float o[8];
#pragma unroll
        for (int e = 0; e < 8; ++e) { const int cg = c8 + e, cv = DFF + c8 + e;
            const unsigned a0 = g0[e >> 1], a1 = g1[e >> 1], a2 = g2[e >> 1], b0 = v0[e >> 1], b1 = v1[e >> 1], b2 = v2[e >> 1];
            const float ga = (e & 1) ? bfhi(a0) : bflo(a0), gb = (e & 1) ? bfhi(a1) : bflo(a1), gc = (e & 1) ? bfhi(a2) : bflo(a2);
            const float va = (e & 1) ? bfhi(b0) : bflo(b0), vb = (e & 1) ? bfhi(b1) : bflo(b1), vc = (e & 1) ? bfhi(b2) : bflo(b2);
            const float gt = cw[cg] * ga + cw[DFF2 + cg] * gb + cw[2 * DFF2 + cg] * gc + cb[cg];
            const float vl = cw[cv] * va + cw[DFF2 + cv] * vb + cw[2 * DFF2 + cv] * vc + cb[cv];
            o[e] = silu(gt) * vl; }
        u32x4 w4; w4.x = pk2(o[0], o[1]); w4.y = pk2(o[2], o[3]); w4.z = pk2(o[4], o[5]); w4.w = pk2(o[6], o[7]);
        *(u32x4*)(gout + (size_t)row * DFF + c8) = w4;
    }
}

__device__ __forceinline__ void phase_final(const Ctx& C) {
    const int gw = C.bid * 8 + C.wave, NGW = C.G * 8, lane = C.lane; const f32x4* gg = (const f32x4*)C.in[I_FNG];
    for (int r = gw; r < TOK; r += NGW) { f32x4* xr = (f32x4*)(C.out + (size_t)r * DM); f32x4 v[4]; float s = 0.f;
#pragma unroll
        for (int j = 0; j < 4; ++j) { v[j] = xr[lane + 64 * j]; s += (v[j][0] * v[j][0] + v[j][1] * v[j][1]) + (v[j][2] * v[j][2] + v[j][3] * v[j][3]); }
        const float rs = 1.0f / sqrtf(wave_sum(s) * (1.0f / DM) + EPS);
#pragma unroll
        for (int j = 0; j < 4; ++j) xr[lane + 64 * j] = v[j] * rs * gg[lane + 64 * j]; }
}

__device__ __forceinline__ int probe_reps(int ph) {
    if (PROBE_KIND == 0) return 1;
    const int lph = ph >= PH_L0 && ph < PH_FINAL ? (ph - PH_L0) % PH_PER_LAYER : -1;
    bool m = false;
    if (PROBE_KIND == 1) m = lph == 2;
    if (PROBE_KIND == 2) m = lph >= 6 && lph <= 13 && ((lph - 6) & 1);
    if (PROBE_KIND == 3) m = lph >= 6 && lph <= 13 && !((lph - 6) & 1);
    if (PROBE_KIND == 4) m = lph == 0;
    if (PROBE_KIND == 5) m = ph == PH_PRO;
    if (PROBE_KIND == 6) m = lph == 4;
    if (PROBE_KIND == 8) m = lph == 1;
    if (PROBE_KIND == 7) m = ph == PH_KV || ph == PH_QV;
    return m ? 2 : 1;
}
__global__ void __launch_bounds__(512, 2) enc_fwd(Args args) {
    extern __shared__ __attribute__((aligned(16))) unsigned char lds_raw[];
    LAS unsigned char* const lds0 = (LAS unsigned char*)lds_raw;
    volatile LAS unsigned* MISC = (volatile LAS unsigned*)(lds0 + MISC_OFF);
    for (int u = threadIdx.x; u < (LDS_BYTES - LDSCTL_OFF) / 4; u += 512) ((LAS unsigned*)(lds0 + LDSCTL_OFF))[u] = 0u;
    __syncthreads();
    XcdBarrier bar; bar.bar = (unsigned*)(args.ws + WS_CTL) + 4096; bar.x = 0; bar.st = nullptr;
    const int lo = args.ph_lo, hi = args.ph_hi;
    const int wave_s = __builtin_amdgcn_readfirstlane(threadIdx.x >> 6);
    if (hi - lo > 1) bar = xcd_barrier_post((unsigned*)(args.ws + WS_CTL) + 4096, MISC + 8);

    for (int ph = lo; ph < hi; ++ph)
    for (int rep = 0; rep < probe_reps(ph); ++rep) {
        if (ph > lo || rep > 0) xcd_barrier(bar);
        unsigned zero_ = 0u; asm volatile("" : "+v"(zero_));
        int tid_ = wave_s * 64 + (int)__builtin_amdgcn_mbcnt_hi(~0u, __builtin_amdgcn_mbcnt_lo(~0u, zero_));
        unsigned char* ws_ = args.ws; asm volatile("" : "+s"(ws_));
        float* out_ = args.out; asm volatile("" : "+s"(out_));
        Ctx C; C.lds = lds0; C.tid = tid_; C.lane = tid_ & 63; C.wave = wave_s; C.G = gridDim.x; C.bid = blockIdx.x;
        C.in = args.in; C.out = out_; C.ws = ws_;
        LAS unsigned char* ring = C.lds; LAS unsigned char* xl = C.lds + XL_OFF;
        const int G = C.G, bid = C.bid;
        float* ssq = (float*)(C.ws + WS_SSQ); const float* tab = (const float*)(C.ws + WS_TAB);
        bf16* xb = (bf16*)(C.ws + WS_XB);
        if (ph == PH_PRO) { phase_prologue(C); continue; }
        if (ph == PH_FINAL) { phase_final(C); continue; }
        int kind = 0; pg8::Gemm g{}; pg8::StaticOrder S{}; pg8::EpiRowBf16 E0{}; pg8::EpiSoftmax E1{}; pg8::EpiResidual E2{};
        int njobs = 1;
        const int lph = (ph - PH_L0) % PH_PER_LAYER, l = ph >= PH_L0 ? (ph - PH_L0) / PH_PER_LAYER : 0;
        if (ph == PH_KV) njobs = 2; else if (ph == PH_QV) njobs = 4;
        else if (lph == 1) { phase_attn12(C); continue; }
        else if (lph == 2) { phase_mixer(C, l); continue; }
        else if (lph >= 6 && lph <= 13 && ((lph - 6) & 1)) { phase_conv(C, l, (lph - 6) >> 1); continue; }
        for (int job = 0; job < njobs; ++job) {
            if (ph == PH_KV) {
                const int ll = job;
                g.A = (const bf16*)(C.ws + WS_MEMN); g.Bt = (const bf16*)(C.ws + WS_WKVT) + (size_t)ll * 2048 * DM; g.K = DM; g.lda = DM; g.ldb = DM; g.ma = pg8::map_rows(DM); g.mb = pg8::map_cols(DM);
                S.init(4, 8, G, (bid + G - 32 * job) % G);
                kind = 0; E0 = pg8::EpiRowBf16{(bf16*)(C.ws + WS_KV) + (size_t)ll * MEMR * 2048, 2048, nullptr, nullptr, 0, 1.0f};
            } else if (ph == PH_QV) {
                const int ll = job >> 1; const bf16* KV = (const bf16*)(C.ws + WS_KV) + (size_t)ll * MEMR * 2048;
                if ((job & 1) == 0) {
                    g.A = KV; g.lda = 2048; g.ma = pg8::OpMap{2, 3, 0, 0, 256 * 2048, 256, 0, 0};
                    g.Bt = (const bf16*)(C.ws + WS_WQ) + (size_t)ll * DM * DM; g.ldb = DM; g.mb = pg8::OpMap{0, 3, 0, 0, 0, 256, 256 * DM, 0}; g.K = 256;
                    S.init(16, 4, G, (bid + G - 64 * job) % G);
                    kind = 0; E0 = pg8::EpiRowBf16{C.wl(ll, WL_QKT), DM, nullptr, nullptr, 0, 0.0625f * LOG2E};
                } else {
                    g.A = (const bf16*)(C.ws + WS_WOT) + (size_t)ll * DM * DM; g.lda = DM; g.ma = pg8::OpMap{0, 0, 0, 3, 256 * DM, 0, 0, 256};
                    g.Bt = KV + 1024; g.ldb = 2048; g.mb = pg8::OpMap{0, 0, 2, 3, 0, 0, 256 * 2048, 256}; g.K = 256;
                    S.init(4, 16, G, (bid + G - 64 * job) % G);
                    kind = 0; E0 = pg8::EpiRowBf16{C.wl(ll, WL_VOT), 4096, nullptr, nullptr, 0, 1.0f};
                }
            } else if (lph == 0) {
                g.A = xb; g.Bt = C.wl(l, WL_WIN); g.K = DM; g.lda = DM; g.ldb = DM; g.ma = pg8::map_rows(DM); g.mb = pg8::map_cols(DM);
                S.init(64, 9, G, bid); kind = 0; E0 = pg8::EpiRowBf16{(bf16*)(C.ws + WS_Z), INWP, tab + l * INWP, ssq, 0, 1.0f};
            } else if (lph == 3) {
                g.A = (const bf16*)(C.ws + WS_Y); g.Bt = C.wl(l, WL_WOUT); g.K = OUTW; g.lda = OUTW; g.ldb = OUTW; g.ma = pg8::map_rows(OUTW); g.mb = pg8::map_cols(OUTW);
                S.init(64, 4, G, bid); kind = 2; E2 = pg8::EpiResidual{l == 0 ? C.in[I_X] : C.out, C.out, xb, C.in[I_BOUT] + l * DM, ssq};
            } else if (lph == 4) {
                g.A = xb; g.Bt = C.wl(l, WL_QKT); g.K = DM; g.lda = DM; g.ldb = DM; g.ma = pg8::map_rows(DM); g.mb = pg8::OpMap{4, 0, 0, 0, 1024 * 1024, 0, 256 * DM, 0};
                S.init(64, 4, G, bid); kind = 1; E1 = pg8::EpiSoftmax{(bf16*)(C.ws + WS_P), ssq};
            } else if (lph == 5) {
                g.A = (const bf16*)(C.ws + WS_P); g.Bt = C.wl(l, WL_VOT); g.K = DM; g.lda = DM; g.ldb = 4096; g.ma = pg8::map_rows(DM); g.mb = pg8::OpMap{4, 0, 0, 0, 1024, 0, 256 * 4096, 0};
                S.init(64, 4, G, bid); kind = 2; E2 = pg8::EpiResidual{C.out, C.out, xb, C.in[I_BO] + l * DM, ssq};
            } else if (lph >= 6 && lph <= 13) {
                const int qd = (lph - 6) >> 1; g.A = xb + (size_t)qd * SEQ * DM; g.Bt = C.wl(l, WL_WUP); g.K = DM; g.lda = DM; g.ldb = DM; g.ma = pg8::map_rows(DM); g.mb = pg8::map_cols(DM);
                S.init(16, 22, G, bid); kind = 0; E0 = pg8::EpiRowBf16{(bf16*)(C.ws + WS_UQ), DFF2, tab + 2 * INWP + l * DFF2, ssq, qd * SEQ, 1.0f};
            } else {
                g.A = (const bf16*)(C.ws + WS_G); g.Bt = C.wl(l, WL_WDOWN); g.K = DFF; g.lda = DFF; g.ldb = DFF; g.ma = pg8::map_rows(DFF); g.mb = pg8::map_cols(DFF);
                S.init(64, 4, G, bid); kind = 2; E2 = pg8::EpiResidual{C.out, C.out, xb, C.in[I_BDOWN] + l * DM, ssq};
            }
            if (kind == 0) pg8::gemm_phase<pg8::EpiRowBf16, pg8::StaticOrder>(ring, xl, g, S, E0, C.tid);
            else if (kind == 1) pg8::gemm_phase<pg8::EpiSoftmax, pg8::StaticOrder>(ring, xl, g, S, E1, C.tid);
            else pg8::gemm_phase<pg8::EpiResidual, pg8::StaticOrder>(ring, xl, g, S, E2, C.tid);
        }
    }
}

extern "C" void kernel_launch(void* const* d_in, const int* in_sizes, int n_in, void* d_out, int out_size, void* d_ws, size_t ws_size, hipStream_t stream) {
    static int grid = 0;
    if (grid == 0) {
        if (n_in != N_IN || in_sizes[0] != TOK * DM || out_size != TOK * DM || ws_size < 256 * MiB) { fprintf(stderr, "kernel_launch: unexpected shapes (n_in %d, in0 %d, out %d, ws %zu)\n", n_in, n_in > 0 ? in_sizes[0] : -1, out_size, ws_size); grid = -1; return; }
        int dev = 0, cus = 0, per_cu = 0;
        if (hipGetDevice(&dev) != hipSuccess || hipDeviceGetAttribute(&cus, hipDeviceAttributeMultiprocessorCount, dev) != hipSuccess) { grid = -1; return; }
        if (hipFuncSetAttribute((const void*)enc_fwd, hipFuncAttributeMaxDynamicSharedMemorySize, LDS_BYTES) != hipSuccess) { fprintf(stderr, "kernel_launch: hipFuncSetAttribute failed\n"); grid = -1; return; }
        if (hipOccupancyMaxActiveBlocksPerMultiprocessor(&per_cu, (const void*)enc_fwd, 512, LDS_BYTES) != hipSuccess || per_cu < 1) fprintf(stderr, "kernel_launch: occupancy query says %d\n", per_cu);
        (void)hipGetLastError();
        grid = cus;
    }
    if (grid < 0) return;
    if (hipMemsetAsync((char*)d_ws + WS_CTL, 0, CTL_ZERO_BYTES, stream) != hipSuccess) return;
    Args a{};
    for (int i = 0; i < N_IN; ++i) a.in[i] = (const float*)d_in[i];
    a.out = (float*)d_out; a.ws = (unsigned char*)d_ws;
#if MK_PER_PHASE
    for (int ph = 0; ph < N_PHASES; ++ph) { a.ph_lo = ph; a.ph_hi = ph + 1; hipLaunchKernelGGL(enc_fwd, dim3(grid), dim3(512), LDS_BYTES, stream, a); }
#else
    a.ph_lo = 0; a.ph_hi = N_PHASES; hipLaunchKernelGGL(enc_fwd, dim3(grid), dim3(512), LDS_BYTES, stream, a);
#endif
}
```

```cpp
#include <hip/hip_runtime.h>
#include <cstdio>
#include <cstdint>

#ifndef PROBE_KIND
#define PROBE_KIND 0
#endif
#ifndef MK_PER_PHASE
#define MK_PER_PHASE 0
#endif

#define LAS __attribute__((address_space(3)))
#define GAS __attribute__((address_space(1)))
typedef unsigned short bf16;
typedef short bf16x8 __attribute__((ext_vector_type(8)));
typedef float f32x4 __attribute__((ext_vector_type(4)));
typedef float f32x2 __attribute__((ext_vector_type(2)));
typedef unsigned u32x4 __attribute__((ext_vector_type(4)));
typedef unsigned u32x2 __attribute__((ext_vector_type(2)));

constexpr int NBATCH = 4, SEQ = 4096, DM = 1024, TOK = NBATCH * SEQ;
constexpr int INW = 2176, INWP = 2304, OUTW = 768, DFF = 2816, DFF2 = 5632, MEML = 256, MEMR = NBATCH * MEML;
constexpr float EPS = 1e-6f;
constexpr float LOG2E = 1.4426950408889634f;
constexpr float QSCALE = 0.125f * LOG2E;

constexpr size_t MiB = 1u << 20;
constexpr size_t WS_CTL = 0, CTL_ZERO_BYTES = 1 * MiB;
constexpr size_t WS_SSQ = 1 * MiB;
constexpr size_t WS_TAB = 2 * MiB;
constexpr size_t WS_WSB = WS_TAB + 128 * 1024, WS_WPT = WS_TAB + 640 * 1024;
constexpr size_t WS_CWP = WS_TAB + 768 * 1024;
constexpr size_t WS_W = 3 * MiB;
constexpr size_t WL_WIN = 0, WL_WOUT = 4608 * 1024, WL_WUP = WL_WOUT + 1536 * 1024, WL_WDOWN = WL_WUP + 11 * MiB, WL_QKT = WL_WDOWN + 5632 * 1024, WL_VOT = WL_QKT + 8 * MiB, WL_STRIDE = WL_VOT + 8 * MiB;
static_assert(WL_STRIDE == 38 * MiB + 512 * 1024, "weights per layer");
constexpr size_t WS_XB = 80 * MiB;
constexpr size_t WS_TR = 112 * MiB;
constexpr size_t WS_Z = WS_TR, WS_Y = WS_TR + 72 * MiB;
constexpr size_t WS_P = WS_TR;
constexpr size_t WS_G = WS_TR, WS_UH = WS_TR + 96 * MiB;
constexpr size_t WS_OG = WS_TR + 122 * MiB, WS_LSE = WS_TR + 130 * MiB;
constexpr size_t WS_WQ = WS_TR + 96 * MiB, WS_WKVT = WS_WQ + 4 * MiB, WS_WOT = WS_WKVT + 8 * MiB, WS_MEMN = WS_WOT + 4 * MiB, WS_KV = WS_MEMN + 2 * MiB, WS_END = WS_KV + 8 * MiB;
static_assert(WS_END <= 256 * MiB && WS_W + 2 * WL_STRIDE <= WS_XB && WS_UH + (size_t)64 * 4 * DFF2 * 4 <= WS_WQ + 38 * MiB, "ws map");

constexpr int RING_BYTES = 131072, XL_OFF = 131072, LDSCTL_OFF = 139264, MISC_OFF = LDSCTL_OFF + 320, LDS_BYTES = 147456;

__device__ __forceinline__ int lane_id() { unsigned z = 0u; asm volatile("" : "+v"(z)); return (int)__builtin_amdgcn_mbcnt_hi(~0u, __builtin_amdgcn_mbcnt_lo(~0u, z)); }
template <int K> __device__ __forceinline__ float xshf(float v) {
    const int x = __builtin_bit_cast(int, v); int r;
    if constexpr (K == 1) r = __builtin_amdgcn_mov_dpp(x, 0xB1, 0xf, 0xf, true);
    else if constexpr (K == 2) r = __builtin_amdgcn_mov_dpp(x, 0x4E, 0xf, 0xf, true);
    else if constexpr (K == 4) r = __builtin_amdgcn_ds_swizzle(x, 0x101F);
    else if constexpr (K == 8) r = __builtin_amdgcn_ds_swizzle(x, 0x201F);
    else r = __builtin_amdgcn_ds_swizzle(x, 0x401F);
    return __builtin_bit_cast(float, r);
}
__device__ __forceinline__ void swap32(float v, float& lo, float& hi) { float a = v, b = v; asm volatile("s_nop 1\n\tv_permlane32_swap_b32 %0, %1" : "+v"(a), "+v"(b)); lo = a; hi = b; }
__device__ __forceinline__ float xsum32(float v) { float a, b; swap32(v, a, b); return a + b; }
__device__ __forceinline__ float xmax32(float v) { float a, b; swap32(v, a, b); return fmaxf(a, b); }

namespace pg8 {
constexpr int BM = 256, BK = 64, HALF = 128, HTB = HALF * BK * 2, STAGE_BYTES = 8 * HTB, NXCD = 8, WGM = 8;
__host__ __device__ __forceinline__ int lds_byte(int r, int c) { const int st = (r >> 4) * 2 + (c >> 5), rr = r & 15, cc = c & 31, ob = rr * 64 + cc * 2; return st * 1024 + (ob ^ (((ob >> 9) & 1) << 5)); }
__host__ __device__ __forceinline__ void stage_rc(int b, int& R, int& C) { const int st = b / 1024, sb = b % 1024, swz = sb ^ (((sb >> 9) & 1) << 5); R = (st >> 1) * 16 + swz / 64; C = (st & 1) * 32 + (swz % 64) / 2; }
__host__ __device__ __forceinline__ int perm32(int rho) { const int n = rho >> 4, i = rho & 15; return 8 * (i >> 2) + 4 * n + (i & 3); }

struct Unit { int pm, pn; };
struct OpMap { int sh_m, mk_m, sh_n, mk_n; int c_mhi, c_mlo, c_nhi, c_nlo;
    __device__ __forceinline__ long long off(const Unit& u) const { return (long long)((u.pm >> sh_m) * c_mhi + (u.pm & mk_m) * c_mlo + (u.pn >> sh_n) * c_nhi + (u.pn & mk_n) * c_nlo); } };
struct Gemm { const bf16* A; const bf16* Bt; int K, lda, ldb; OpMap ma, mb; };
__device__ __forceinline__ OpMap map_rows(int ld) { OpMap m{0, 0, 0, 0, 0, 0, 0, 0}; m.c_mhi = 256 * ld; return m; }
__device__ __forceinline__ OpMap map_cols(int ld) { OpMap m{0, 0, 0, 0, 0, 0, 0, 0}; m.c_nhi = 256 * ld; return m; }

struct StaticOrder {
    int nM, nN, nwg, G, c;
    __device__ void init(int nM_, int nN_, int G_, int c_) { nM = nM_; nN = nN_; nwg = nM * nN; G = G_; c = c_; }
    __device__ bool next(int i, Unit& u) const {
        const long L = (long)i * G + c; if (L >= nwg) return false;
        int wgid = (int)L; { const int q = nwg / NXCD, r = nwg % NXCD, xcd = wgid % NXCD, off = wgid / NXCD; wgid = (xcd < r ? xcd * (q + 1) : r * (q + 1) + (xcd - r) * q) + off; }
        const int nig = WGM * nN, gid = wgid / nig, fm = gid * WGM, gsz = (nM - fm) < WGM ? (nM - fm) : WGM;
        u.pm = fm + ((wgid % nig) % gsz); u.pn = (wgid % nig) / gsz; return true;
    }
};

__device__ __forceinline__ unsigned cvt_pk_bf16(float lo, float hi) { unsigned r; asm volatile("v_cvt_pk_bf16_f32 %0, %1, %2" : "=v"(r) : "v"(lo), "v"(hi)); return r; }

struct EpiP { void* p0; const float* p1; const float* p2; const float* p3; void* p4; int i0; float f0; };
__device__ __forceinline__ void rstd8(const float* ssq, int row0  , int fq, float (&rs)[2][4], float mul) {
    f32x4 p[2][4];
#pragma unroll
    for (int ai = 0; ai < 2; ++ai)
#pragma unroll
        for (int m = 0; m < 4; ++m) p[ai][m] = *(const GAS f32x4*)(ssq + (size_t)(row0 + ai * HALF + m * 16) * 16 + fq * 4);
#pragma unroll
    for (int ai = 0; ai < 2; ++ai)
#pragma unroll
        for (int m = 0; m < 4; ++m) { float s = (p[ai][m][0] + p[ai][m][1]) + (p[ai][m][2] + p[ai][m][3]); s += xshf<16>(s); s = xsum32(s);
            rs[ai][m] = mul / sqrtf(s * (1.0f / DM) + EPS); }
}
struct EpiRowBf16 {
    static constexpr bool PERM = true;
    EpiP P;
    __device__ __forceinline__ void operator()(f32x4 (&acc)[2][2][4][2], const Unit& u, int wr, int wc, int fr, int fq, LAS unsigned char*, int, int) const {
        bf16* O = (bf16*)P.p0; const int ldc = P.i0; const float* bias = P.p1; const float* ssq = P.p2; const float cscale = P.f0;
        const int rowt = u.pm * BM + wr * 64 + fr, col0 = u.pn * BM + wc * 32 + 8 * fq;
        float rs[2][4];
        if (ssq) rstd8(ssq, rowt, fq, rs, cscale);
        else {
#pragma unroll
            for (int ai = 0; ai < 2; ++ai)
#pragma unroll
                for (int m = 0; m < 4; ++m) rs[ai][m] = cscale; }
        f32x4 bv[2][2];
#pragma unroll
        for (int bj = 0; bj < 2; ++bj)
#pragma unroll
            for (int n = 0; n < 2; ++n) bv[bj][n] = bias ? *(const GAS f32x4*)(bias + col0 + bj * HALF + 4 * n) : (f32x4){0.f, 0.f, 0.f, 0.f};
#pragma unroll
        for (int ai = 0; ai < 2; ++ai)
#pragma unroll
            for (int m = 0; m < 4; ++m) { bf16* rowp = O + (size_t)(rowt + ai * HALF + m * 16) * ldc + col0; const float r = rs[ai][m];
#pragma unroll
                for (int bj = 0; bj < 2; ++bj) { const f32x4 v0 = acc[ai][bj][m][0] * r + bv[bj][0], v1 = acc[ai][bj][m][1] * r + bv[bj][1];
                    u32x4 w; w.x = cvt_pk_bf16(v0[0], v0[1]); w.y = cvt_pk_bf16(v0[2], v0[3]); w.z = cvt_pk_bf16(v1[0], v1[1]); w.w = cvt_pk_bf16(v1[2], v1[3]);
                    *(GAS u32x4*)(rowp + bj * HALF) = w; } }
    }
};
struct EpiSoftmax {
    static constexpr bool PERM = true;
    EpiP Q;
    __device__ __forceinline__ void operator()(f32x4 (&acc)[2][2][4][2], const Unit& u, int wr, int wc, int fr, int fq, LAS unsigned char* xl, int, int) const {
        bf16* P = (bf16*)Q.p0; const float* ssq = Q.p2;
        const int rowt = u.pm * BM + wr * 64 + fr, col0 = u.pn * BM + wc * 32 + 8 * fq;
        LAS f32x2* X = (LAS f32x2*)xl;
        float ml[2][4], rs[2][4];
        rstd8(ssq, rowt, fq, rs, 1.0f);
#pragma unroll
        for (int ai = 0; ai < 2; ++ai)
#pragma unroll
            for (int m = 0; m < 4; ++m) {
                const float r = rs[ai][m];
                float mx = -3.0e38f;
#pragma unroll
                for (int bj = 0; bj < 2; ++bj)
#pragma unroll
                    for (int n = 0; n < 2; ++n) { f32x4 v = acc[ai][bj][m][n] * r; acc[ai][bj][m][n] = v; mx = fmaxf(fmaxf(fmaxf(v[0], v[1]), fmaxf(v[2], v[3])), mx); }
                mx = fmaxf(mx, xshf<16>(mx)); mx = xmax32(mx);
                float l = 0.f;
#pragma unroll
                for (int bj = 0; bj < 2; ++bj)
#pragma unroll
                    for (int n = 0; n < 2; ++n) { f32x4 v = acc[ai][bj][m][n]; v[0] = __builtin_amdgcn_exp2f(v[0] - mx); v[1] = __builtin_amdgcn_exp2f(v[1] - mx); v[2] = __builtin_amdgcn_exp2f(v[2] - mx); v[3] = __builtin_amdgcn_exp2f(v[3] - mx);
                        acc[ai][bj][m][n] = v; l += (v[0] + v[1]) + (v[2] + v[3]); }
                l += xshf<16>(l); l = xsum32(l);
                ml[ai][m] = mx;
                if (fq == 0) X[(ai * HALF + wr * 64 + m * 16 + fr) * 4 + wc] = (f32x2){mx, l};
            }
        asm volatile("s_waitcnt lgkmcnt(0)" ::: "memory"); __builtin_amdgcn_s_barrier(); asm volatile("" ::: "memory");
#pragma unroll
        for (int ai = 0; ai < 2; ++ai)
#pragma unroll
            for (int m = 0; m < 4; ++m) {
                const LAS f32x2* xr = X + (ai * HALF + wr * 64 + m * 16 + fr) * 4;
                const f32x2 a = xr[0], b = xr[1], c = xr[2], d = xr[3];
                const float M = fmaxf(fmaxf(a.x, b.x), fmaxf(c.x, d.x));
                const float L = (a.y * __builtin_amdgcn_exp2f(a.x - M) + b.y * __builtin_amdgcn_exp2f(b.x - M)) + (c.y * __builtin_amdgcn_exp2f(c.x - M) + d.y * __builtin_amdgcn_exp2f(d.x - M));
                const float f = __builtin_amdgcn_exp2f(ml[ai][m] - M) / L;
                bf16* rowp = P + (size_t)(rowt + ai * HALF + m * 16) * DM + col0;
#pragma unroll
                for (int bj = 0; bj < 2; ++bj) { const f32x4 v0 = acc[ai][bj][m][0] * f, v1 = acc[ai][bj][m][1] * f;
                    u32x4 w; w.x = cvt_pk_bf16(v0[0], v0[1]); w.y = cvt_pk_bf16(v0[2], v0[3]); w.z = cvt_pk_bf16(v1[0], v1[1]); w.w = cvt_pk_bf16(v1[2], v1[3]);
                    *(GAS u32x4*)(rowp + bj * HALF) = w; }
            }
    }
};
struct EpiResidual {
    static constexpr bool PERM = false;
    EpiP P;
    __device__ __forceinline__ void operator()(f32x4 (&acc)[2][2][4][2], const Unit& u, int wr, int wc, int fr, int fq, LAS unsigned char*, int, int) const {
        const float* xold = P.p3; float* xnew = (float*)P.p4; bf16* xb = (bf16*)P.p0; const float* bias = P.p1; float* ssq = (float*)P.p2;
        const int row0 = u.pm * BM + wr * 64 + fr, col0 = u.pn * BM + wc * 32 + 4 * fq;
        f32x4 bv[2][2];
#pragma unroll
        for (int bj = 0; bj < 2; ++bj)
#pragma unroll
            for (int n = 0; n < 2; ++n) bv[bj][n] = *(const GAS f32x4*)(bias + col0 + bj * HALF + n * 16);
#pragma unroll
        for (int ai = 0; ai < 2; ++ai)
#pragma unroll
            for (int m = 0; m < 4; ++m) { int row = row0 + ai * HALF + m * 16; asm volatile("" : "+v"(row)); const size_t off = (size_t)row * DM + col0; float sq = 0.f;
#pragma unroll
                for (int bj = 0; bj < 2; ++bj)
#pragma unroll
                    for (int n = 0; n < 2; ++n) { const f32x4 xo = *(const GAS f32x4*)(xold + off + bj * HALF + n * 16); const f32x4 v = (acc[ai][bj][m][n] + bv[bj][n]) + xo;
                        *(GAS f32x4*)(xnew + off + bj * HALF + n * 16) = v; sq += (v[0] * v[0] + v[1] * v[1]) + (v[2] * v[2] + v[3] * v[3]);
                        u32x2 w; w.x = cvt_pk_bf16(v[0], v[1]); w.y = cvt_pk_bf16(v[2], v[3]); *(GAS u32x2*)(xb + off + bj * HALF + n * 16) = w; }
                sq += xshf<16>(sq); sq = xsum32(sq);
                if (fq == 0) *(GAS float*)(ssq + (size_t)row * 16 + u.pn * 4 + wc) = sq;
                asm volatile("" ::: "memory"); }
    }
};

template <int CTRL> __device__ __forceinline__ float dpp_mov(float old, float src) {
    return __builtin_bit_cast(float, __builtin_amdgcn_update_dpp(__builtin_bit_cast(int, old), __builtin_bit_cast(int, src), CTRL, 0xf, 0xf, false)); }
struct EpiConvGate {
    static constexpr bool PERM = true;
    EpiP P;
    __device__ __forceinline__ void operator()(f32x4 (&acc)[2][2][4][2], const Unit& u, int wr, int wc, int fr, int fq, LAS unsigned char* xl, int wid, int) const {
        bf16* G = (bf16*)P.p0; const float* bias = P.p1; const float* ssq = P.p2; const float* cwp = P.p3; float* uh = (float*)P.p4;
        const int rowt = u.pm * BM + wr * 64 + fr, colu = u.pn * BM + wc * 32 + 8 * fq;
        { float rs[2][4]; rstd8(ssq, rowt, fq, rs, 1.0f);
#pragma unroll
          for (int bj = 0; bj < 2; ++bj)
#pragma unroll
              for (int n = 0; n < 2; ++n) { const f32x4 bv = *(const GAS f32x4*)(bias + colu + bj * HALF + 4 * n);
#pragma unroll
                  for (int ai = 0; ai < 2; ++ai)
#pragma unroll
                      for (int m = 0; m < 4; ++m) acc[ai][bj][m][n] = acc[ai][bj][m][n] * rs[ai][m] + bv; } }
        LAS float* X = (LAS float*)xl;
#pragma unroll
        for (int ai = 0; ai < 2; ++ai) {
            if (fr == 0) {
#pragma unroll
                for (int bj = 0; bj < 2; ++bj)
#pragma unroll
                    for (int n = 0; n < 2; ++n) *(LAS f32x4*)(X + ((wid * 2 + ai) * 2 + 0) * 64 + fq * 16 + bj * 8 + n * 4) = acc[ai][bj][0][n]; }
            if (fr == 15) {
#pragma unroll
                for (int bj = 0; bj < 2; ++bj)
#pragma unroll
                    for (int n = 0; n < 2; ++n) *(LAS f32x4*)(X + ((wid * 2 + ai) * 2 + 1) * 64 + fq * 16 + bj * 8 + n * 4) = acc[ai][bj][3][n]; }
        }
        if (wr == 0 && fr < 2) {
#pragma unroll
            for (int bj = 0; bj < 2; ++bj)
#pragma unroll
                for (int n = 0; n < 2; ++n) *(GAS f32x4*)(uh + (size_t)(u.pm * 4 + fr) * DFF2 + colu + bj * HALF + 4 * n) = acc[0][bj][0][n]; }
        if (wr == 1 && fr >= 14) {
#pragma unroll
            for (int bj = 0; bj < 2; ++bj)
#pragma unroll
                for (int n = 0; n < 2; ++n) *(GAS f32x4*)(uh + (size_t)(u.pm * 4 + 2 + (fr - 14)) * DFF2 + colu + bj * HALF + 4 * n) = acc[1][bj][3][n]; }
        asm volatile("s_waitcnt lgkmcnt(0)" ::: "memory"); __builtin_amdgcn_s_barrier(); asm volatile("" ::: "memory");
        u32x2 outw[2][4][2];
#pragma unroll
        for (int n = 0; n < 2; ++n) {
            f32x4 wg[4], wv[4];
#pragma unroll
            for (int j = 0; j < 4; ++j) { wg[j] = *(const GAS f32x4*)(cwp + (size_t)j * DFF2 + colu + 4 * n); wv[j] = *(const GAS f32x4*)(cwp + (size_t)j * DFF2 + colu + HALF + 4 * n); }
#pragma unroll
            for (int ai = 0; ai < 2; ++ai) {
                f32x4 xu[2], xd[2];
                { const bool hasu = !(wr == 0 && ai == 0), hasd = !(wr == 1 && ai == 1);
                  const int wu = (wr == 1) ? wc : 4 + wc, au = (wr == 1) ? ai : 0;
                  const int wd = (wr == 0) ? 4 + wc : wc, ad = (wr == 0) ? ai : 1;
#pragma unroll
                  for (int bj = 0; bj < 2; ++bj) {
                      xu[bj] = hasu ? *(const LAS f32x4*)(X + ((wu * 2 + au) * 2 + 1) * 64 + fq * 16 + bj * 8 + n * 4) : (f32x4){0.f, 0.f, 0.f, 0.f};
                      xd[bj] = hasd ? *(const LAS f32x4*)(X + ((wd * 2 + ad) * 2 + 0) * 64 + fq * 16 + bj * 8 + n * 4) : (f32x4){0.f, 0.f, 0.f, 0.f}; } }
#pragma unroll
                for (int m = 0; m < 4; ++m) {
                    float cv[2][4];
#pragma unroll
                    for (int bj = 0; bj < 2; ++bj)
#pragma unroll
                        for (int i = 0; i < 4; ++i) { const float cur = acc[ai][bj][m][n][i];
                            const float tu = (m == 0) ? xu[bj][i] : dpp_mov<0x121>(0.f, acc[ai][bj][m == 0 ? 0 : m - 1][n][i]);
                            const float up = dpp_mov<0x111>(tu, cur);
                            const float td = (m == 3) ? xd[bj][i] : dpp_mov<0x12F>(0.f, acc[ai][bj][m == 3 ? 3 : m + 1][n][i]);
                            const float dn = dpp_mov<0x101>(td, cur);
                            const f32x4& w0 = bj ? wv[0] : wg[0]; const f32x4& w1 = bj ? wv[1] : wg[1]; const f32x4& w2 = bj ? wv[2] : wg[2]; const f32x4& wb = bj ? wv[3] : wg[3];
                            cv[bj][i] = (w0[i] * up + w1[i] * cur) + (w2[i] * dn + wb[i]); }
                    float go[4];
#pragma unroll
                    for (int i = 0; i < 4; ++i) go[i] = cv[0][i] / (1.0f + __builtin_amdgcn_exp2f(-LOG2E * cv[0][i])) * cv[1][i];
                    outw[ai][m][n].x = cvt_pk_bf16(go[0], go[1]); outw[ai][m][n].y = cvt_pk_bf16(go[2], go[3]);
                }
            }
        }
        const int seqt = u.pm & 15;
#pragma unroll
        for (int ai = 0; ai < 2; ++ai)
#pragma unroll
            for (int m = 0; m < 4; ++m) {
                const bool skip = (wr == 0 && ai == 0 && m == 0 && fr == 0 && seqt != 0) || (wr == 1 && ai == 1 && m == 3 && fr == 15 && seqt != 15);
                if (!skip) { u32x4 w; w.x = outw[ai][m][0].x; w.y = outw[ai][m][0].y; w.z = outw[ai][m][1].x; w.w = outw[ai][m][1].y;
                    *(GAS u32x4*)(G + (size_t)(rowt + ai * HALF + m * 16) * DFF + u.pn * HALF + wc * 32 + 8 * fq) = w; } }
    }
};

template <class Epi, class Sched>
__device__ __forceinline__ void gemm_phase(LAS unsigned char* lds, LAS unsigned char* xl, const Gemm g, const Sched& S, const Epi& E, const int wid) {
    const int lane = lane_id(), tid = lane + 64 * wid;
    const int wr = wid >> 2, wc = wid & 3, fr = lane & 15, fq = lane >> 4;
    const int K = g.K, nt = K / BK;
    unsigned voffA[2], voffB[2];
#pragma unroll
    for (int i = 0; i < 2; ++i) { int R, C; stage_rc(tid * 16 + i * 8192, R, C); const int Rb = Epi::PERM ? ((R & ~31) + perm32(R & 31)) : R;
        voffA[i] = (unsigned)(R * g.lda + C) * 2u; voffB[i] = (unsigned)(Rb * g.ldb + C) * 2u; }
    const size_t kstep = (size_t)(BK * 2);
    const size_t hstepA = (size_t)HALF * g.lda * 2, hstepB = (size_t)HALF * g.ldb * 2;
    const unsigned ldsw = (unsigned)wid * 1024u;
    const int aoff = lds_byte(wr * 64 + fr, fq * 8), boff = lds_byte(wc * 32 + fr, fq * 8);
#define PG8_SA(b, h) (((b) * 2 + (h)) * HTB)
#define PG8_SB(b, h) ((4 + (b) * 2 + (h)) * HTB)
#define PG8_STAGE(bufoff, gbase, voff) do { _Pragma("unroll") for (int _i = 0; _i < 2; ++_i) \
        __builtin_amdgcn_global_load_lds((const unsigned*)((const char*)(gbase) + (voff)[_i]), (LAS unsigned*)(lds + (bufoff) + ldsw + _i * 8192), 16, 0, 0); } while (0)
#define PG8_LDA(dst, b, h) do { _Pragma("unroll") for (int m = 0; m < 4; ++m) _Pragma("unroll") for (int k = 0; k < 2; ++k) dst[m][k] = *(const LAS bf16x8*)(lds + PG8_SA(b, h) + aoff + m * 2048 + k * 1024); } while (0)
#define PG8_LDB(dst, b, h) do { _Pragma("unroll") for (int n = 0; n < 2; ++n) _Pragma("unroll") for (int k = 0; k < 2; ++k) dst[n][k] = *(const LAS bf16x8*)(lds + PG8_SB(b, h) + boff + n * 2048 + k * 1024); } while (0)
#define PG8_MMA(ai, bj, At, Bt) do { __builtin_amdgcn_s_setprio(1); _Pragma("unroll") for (int m = 0; m < 4; ++m) _Pragma("unroll") for (int n = 0; n < 2; ++n) _Pragma("unroll") for (int k = 0; k < 2; ++k) \
        acc[ai][bj][m][n] = __builtin_amdgcn_mfma_f32_16x16x32_bf16(Bt[n][k], At[m][k], acc[ai][bj][m][n], 0, 0, 0); __builtin_amdgcn_s_setprio(0); } while (0)
#define PG8_WAIT_V(n) asm volatile("s_waitcnt vmcnt(" #n ")" ::: "memory")
#define PG8_WAIT_L(n) asm volatile("s_waitcnt lgkmcnt(" #n ")" ::: "memory")
#define PG8_BAR __builtin_amdgcn_s_barrier()
#define PG8_SCHED __builtin_amdgcn_sched_barrier(0)
    Unit cur, nxt; int ui = 0;
    if (!S.next(0, cur)) return;
    f32x4 acc[2][2][4][2];
#pragma unroll
    for (int a = 0; a < 2; ++a)
#pragma unroll
        for (int b = 0; b < 2; ++b)
#pragma unroll
            for (int m = 0; m < 4; ++m)
#pragma unroll
                for (int n = 0; n < 2; ++n) acc[a][b][m][n] = (f32x4){0.f, 0.f, 0.f, 0.f};
    bf16x8 At[4][2], B0[2][2], B1[2][2];
    const char* cA = (const char*)(g.A + g.ma.off(cur)); const char* cB = (const char*)(g.Bt + g.mb.off(cur));
    PG8_STAGE(PG8_SB(0, 0), cB, voffB); PG8_STAGE(PG8_SB(0, 1), cB + hstepB, voffB); PG8_STAGE(PG8_SA(0, 0), cA, voffA); PG8_STAGE(PG8_SA(0, 1), cA + hstepA, voffA);
    if (wr == 1) PG8_BAR;
    PG8_WAIT_V(2); PG8_BAR;
    PG8_STAGE(PG8_SB(1, 0), cB + kstep, voffB); PG8_STAGE(PG8_SA(1, 0), cA + kstep, voffA); PG8_STAGE(PG8_SB(1, 1), cB + hstepB + kstep, voffB);
    PG8_WAIT_V(6); PG8_BAR;
    for (;;) {
        const bool has_next = S.next(ui + 1, nxt);
        const char* nA = has_next ? (const char*)(g.A + g.ma.off(nxt)) : cA; const char* nB = has_next ? (const char*)(g.Bt + g.mb.off(nxt)) : cB;
        for (int t = 0; t < nt; t += 2) {
            const bool last = (t == nt - 2);
            const char* a1 = cA + (size_t)(t + 1) * kstep;
            const char* a2 = last ? nA : cA + (size_t)(t + 2) * kstep; const char* b2 = last ? nB : cB + (size_t)(t + 2) * kstep;
            const char* a3 = a2 + kstep; const char* b3 = b2 + kstep;
            PG8_LDB(B0, 0, 0); PG8_LDB(B1, 0, 1); PG8_SCHED; PG8_LDA(At, 0, 0); PG8_STAGE(PG8_SA(1, 1), a1 + hstepA, voffA);
            PG8_WAIT_V(8); PG8_WAIT_L(0); PG8_BAR; PG8_MMA(0, 0, At, B0); PG8_MMA(0, 1, At, B1); PG8_BAR; PG8_SCHED;
            PG8_LDA(At, 0, 1); PG8_STAGE(PG8_SB(0, 0), b2, voffB); PG8_STAGE(PG8_SB(0, 1), b2 + hstepB, voffB); PG8_STAGE(PG8_SA(0, 0), a2, voffA);
            PG8_WAIT_V(8); PG8_WAIT_L(0); PG8_BAR; PG8_MMA(1, 0, At, B0); PG8_MMA(1, 1, At, B1); PG8_BAR; PG8_SCHED;
            PG8_LDB(B0, 1, 0); PG8_LDB(B1, 1, 1); PG8_SCHED; PG8_LDA(At, 1, 0); PG8_STAGE(PG8_SA(0, 1), a2 + hstepA, voffA);
            PG8_WAIT_V(8); PG8_WAIT_L(0); PG8_BAR; PG8_MMA(0, 0, At, B0); PG8_MMA(0, 1, At, B1); PG8_BAR; PG8_SCHED;
            PG8_LDA(At, 1, 1); PG8_STAGE(PG8_SB(1, 0), b3, voffB); PG8_STAGE(PG8_SB(1, 1), b3 + hstepB, voffB); PG8_STAGE(PG8_SA(1, 0), a3, voffA);
            PG8_WAIT_V(8); PG8_WAIT_L(0); PG8_BAR; PG8_MMA(1, 0, At, B0); PG8_MMA(1, 1, At, B1); PG8_BAR; PG8_SCHED;
        }
        if (wr == 0) PG8_BAR;
        { const int lane_ = lane_id();
          E(acc, cur, wr, wc, lane_ & 15, lane_ >> 4, xl, wid, lane_); }
        if (!has_next) break;
#pragma unroll
        for (int a = 0; a < 2; ++a)
#pragma unroll
            for (int b = 0; b < 2; ++b)
#pragma unroll
                for (int m = 0; m < 4; ++m)
#pragma unroll
                    for (int n = 0; n < 2; ++n) acc[a][b][m][n] = (f32x4){0.f, 0.f, 0.f, 0.f};
        cur = nxt; cA = nA; cB = nB; ++ui;
        if (wr == 1) PG8_BAR;
    }
    PG8_WAIT_V(0);
    PG8_BAR;
#undef PG8_SA
#undef PG8_SB
#undef PG8_STAGE
#undef PG8_LDA
#undef PG8_LDB
#undef PG8_MMA
#undef PG8_WAIT_V
#undef PG8_WAIT_L
#undef PG8_BAR
#undef PG8_SCHED
}
}

typedef GAS unsigned gu32;
#define RLX_AGENT __ATOMIC_RELAXED, __HIP_MEMORY_SCOPE_AGENT
#define LDS_WAIT() asm volatile("s_waitcnt lgkmcnt(0)" ::: "memory")
#define VM_WAIT() asm volatile("s_waitcnt vmcnt(0)" ::: "memory")
__device__ __forceinline__ unsigned f2bf(float f) { unsigned u = __builtin_bit_cast(unsigned, f); return (u + 0x7fffu + ((u >> 16) & 1u)) >> 16; }
__device__ __forceinline__ unsigned pk2(float lo, float hi) { return f2bf(lo) | (f2bf(hi) << 16); }
__device__ __forceinline__ float bf2f(unsigned short h) { return __builtin_bit_cast(float, (unsigned)h << 16); }
__device__ __forceinline__ float bflo(unsigned w) { return __builtin_bit_cast(float, w << 16); }
__device__ __forceinline__ float bfhi(unsigned w) { return __builtin_bit_cast(float, w & 0xffff0000u); }
__device__ __forceinline__ float wave_sum(float v) { v += xshf<1>(v); v += xshf<2>(v); v += xshf<4>(v); v += xshf<8>(v); v += xshf<16>(v); return xsum32(v); }
__device__ __forceinline__ float gelu_tanh(float x) { const float u = 0.7978845608028654f * (x + 0.044715f * x * x * x); return x / (1.0f + __expf(-2.0f * u)); }
__device__ __forceinline__ float silu(float x) { return x / (1.0f + __expf(-x)); }

#define XB_TMO      128
#define XB_XCNT(j)  (256  + 64 * (j))
#define XB_XSUB(j)  (1280 + 64 * (j))
#define XB_XGEN(j)  (2304 + 64 * (j))
#define XB_TOP      3328
#define XB_TOPGEN   3392
#define XCD_BAR_WORDS 3456
#define XB_SPIN_CAP (1u << 18)
__device__ __forceinline__ unsigned xb_ld(unsigned* p)              { return __hip_atomic_load(p, __ATOMIC_RELAXED, __HIP_MEMORY_SCOPE_AGENT); }
__device__ __forceinline__ unsigned xb_add(unsigned* p, unsigned v) { return __hip_atomic_fetch_add(p, v, __ATOMIC_RELAXED, __HIP_MEMORY_SCOPE_AGENT); }
__device__ __forceinline__ unsigned xb_xcc_id() { return (unsigned)__builtin_amdgcn_s_getreg((3 << 11) | 20) & 0xFu; }
#define XB_SPIN(cond, bar) do { unsigned _sp = 0; while (cond) { __builtin_amdgcn_s_sleep(1); \
    if ((++_sp & 255u) == 0u) { if (xb_ld(&(bar)[XB_TMO])) break; if (_sp > XB_SPIN_CAP) { atomicAdd(&(bar)[XB_TMO], 1u); break; } } } } while (0)
struct XcdBarrier { unsigned* bar; unsigned x; volatile LAS unsigned* st; };
__device__ __forceinline__ XcdBarrier xcd_barrier_post(unsigned* bar, volatile LAS unsigned* st) {
    XcdBarrier b; b.bar = bar; b.x = xb_xcc_id(); b.st = st;
    if (threadIdx.x == 0) (void)xb_add(&bar[XB_XCNT(b.x)], 1u);
    return b;
}
__device__ __forceinline__ void xcd_barrier_complete(unsigned* bar, unsigned x, unsigned& nloc, unsigned& nx) {
    const unsigned G = gridDim.x * gridDim.y * gridDim.z;
    unsigned sum, cnt, mine, sp = 0u;
    for (;;) {
        sum = 0u; cnt = 0u; mine = 0u;
#pragma unroll
        for (unsigned j = 0; j < 16; ++j) { const unsigned c = xb_ld(&bar[XB_XCNT(j)]); sum += c; cnt += (c > 0u) ? 1u : 0u; mine = (j == x) ? c : mine; }
        if (sum == G) break;
        __builtin_amdgcn_s_sleep(1);
        if ((++sp & 255u) == 0u) { if (xb_ld(&bar[XB_TMO])) break; if (sp > XB_SPIN_CAP) { atomicAdd(&bar[XB_TMO], 1u); break; } }
    }
    nloc = mine > 0u ? mine : 1u; nx = cnt > 0u ? cnt : 1u;
}
__device__ __forceinline__ void xcd_barrier(const XcdBarrier& b) {
    asm volatile("s_waitcnt vmcnt(0)" ::: "memory");
    __syncthreads();
    if (threadIdx.x == 0) {
        unsigned* bar = b.bar;
        __builtin_amdgcn_s_waitcnt(0);
        unsigned nloc = b.st[0], nx = b.st[1];
        if (nloc == 0u) { xcd_barrier_complete(bar, b.x, nloc, nx); b.st[0] = nloc; b.st[1] = nx; }
        const unsigned old = xb_add(&bar[XB_XSUB(b.x)], 1u);
        const unsigned gen = old / nloc;
        if (old + 1u == (gen + 1u) * nloc) {
            __builtin_amdgcn_fence(__ATOMIC_RELEASE, "agent");
            asm volatile("s_waitcnt vmcnt(0)" ::: "memory");
            const unsigned og = xb_add(&bar[XB_TOP], 1u);
            const unsigned tg = og / nx;
            if (og + 1u == (tg + 1u) * nx) xb_add(&bar[XB_TOPGEN], 1u);
            else XB_SPIN(xb_ld(&bar[XB_TOPGEN]) == tg, bar);
            __builtin_amdgcn_fence(__ATOMIC_ACQUIRE, "agent");
            xb_add(&bar[XB_XGEN(b.x)], 1u);
            asm volatile("s_waitcnt vmcnt(0)" ::: "memory");
        } else {
            XB_SPIN(xb_ld(&bar[XB_XGEN(b.x)]) == gen, bar);
            __builtin_amdgcn_fence(__ATOMIC_ACQUIRE, "agent");
            asm volatile("s_waitcnt vmcnt(0)" ::: "memory");
        }
    }
    __syncthreads();
}

enum { I_X = 0, I_MEM, I_REL, I_MEMG, I_NMIXG, I_WIN, I_BIN, I_VG, I_WS, I_BS, I_PW, I_PB, I_PSC, I_WOUT, I_BOUT, I_NMEMG, I_WQ, I_WKV, I_WO, I_BO, I_NFFNG, I_WUP, I_BUP, I_CW, I_CB, I_WDOWN, I_BDOWN, I_FNG, N_IN };
struct Args { const float* in[N_IN]; float* out; unsigned char* ws; int ph_lo, ph_hi; };
constexpr int PH_PRO = 0, PH_L0 = 1, PH_PER_LAYER = 9, PH_FINAL = PH_L0 + 2 * PH_PER_LAYER, N_PHASES = PH_FINAL + 1;

struct Ctx {
    LAS unsigned char* lds; int wave, G, bid;
    const float* const* in; float* out; unsigned char* ws;
    __device__ __forceinline__ bf16* wl(int l, size_t off) const { return (bf16*)(ws + WS_W + (size_t)l * WL_STRIDE + off); }
};

__device__ __forceinline__ void tr_item(const float* W, int ldw, const float* gain, bf16* WT, int K, int k0, int n0, int drow0, LAS float* scr, int lane, float cs = 1.0f) {
#pragma unroll 8
    for (int i = 0; i < 32; ++i) { const int kk = 2 * i + (lane >> 5); float v = W[(size_t)(k0 + kk) * ldw + n0 + (lane & 31)] * cs; if (gain) v *= gain[k0 + kk]; scr[kk * 33 + (lane & 31)] = v; }
    LDS_WAIT(); asm volatile("" ::: "memory");
    const int c = lane & 7;
#pragma unroll
    for (int j = 0; j < 4; ++j) { const int n = (lane >> 3) + 8 * j; const LAS float* s = scr + (8 * c) * 33 + n;
        u32x4 o; o.x = pk2(s[0 * 33], s[1 * 33]); o.y = pk2(s[2 * 33], s[3 * 33]); o.z = pk2(s[4 * 33], s[5 * 33]); o.w = pk2(s[6 * 33], s[7 * 33]);
        *(u32x4*)(WT + (size_t)(drow0 + n) * K + k0 + 8 * c) = o; }
    LDS_WAIT(); asm volatile("" ::: "memory");
}
__device__ __forceinline__ void phase_prologue(const Ctx& C) {
    LAS float* scr = (LAS float*)(C.lds + C.wave * 16384);
    const int lane = lane_id(), tid = lane + 64 * C.wave; (void)tid;
    const int gw = C.bid * 8 + C.wave, NGW = C.G * 8;
    constexpr int I_IN = 16 * 68, I_OUT = 12 * 32, I_KV = 16 * 64, I_O = 16 * 32, I_UP = 16 * 176, I_DN = 44 * 32, I_L = I_IN + I_OUT + I_KV + I_O + I_UP + I_DN;
    for (int it = gw; it < 2 * I_L; it += NGW) {
        const int l = it / I_L; int r = it % I_L;
        if (r < I_IN) { const int kb = r / 68, nb = r % 68; tr_item(C.in[I_WIN] + (size_t)l * DM * INW, INW, C.in[I_NMIXG] + l * DM, C.wl(l, WL_WIN), DM, kb * 64, nb * 32, nb * 32, scr, lane, (nb * 32 >= 1024 && nb * 32 < 1408) ? QSCALE : 1.0f); continue; } r -= I_IN;
        if (r < I_OUT) { const int kb = r / 32, nb = r % 32; tr_item(C.in[I_WOUT] + (size_t)l * OUTW * DM, DM, nullptr, C.wl(l, WL_WOUT), OUTW, kb * 64, nb * 32, nb * 32, scr, lane); continue; } r -= I_OUT;
        if (r < I_KV) { const int kb = r / 64, nb = r % 64; tr_item(C.in[I_WKV] + (size_t)l * DM * 2048, 2048, nullptr, (bf16*)(C.ws + WS_WKVT) + (size_t)l * 2048 * DM, DM, kb * 64, nb * 32, nb * 32, scr, lane); continue; } r -= I_KV;
        if (r < I_O) { const int kb = r / 32, nb = r % 32; tr_item(C.in[I_WO] + (size_t)l * DM * DM, DM, nullptr, (bf16*)(C.ws + WS_WOT) + (size_t)l * DM * DM, DM, kb * 64, nb * 32, nb * 32, scr, lane); continue; } r -= I_O;
        if (r < I_UP) { const int kb = r / 176, nb = r % 176; const int n0 = nb * 32; const int drow = n0 < DFF ? (n0 / 128) * 256 + (n0 % 128) : ((n0 - DFF) / 128) * 256 + 128 + ((n0 - DFF) % 128);
            tr_item(C.in[I_WUP] + (size_t)l * DM * DFF2, DFF2, C.in[I_NFFNG] + l * DM, C.wl(l, WL_WUP), DM, kb * 64, n0, drow, scr, lane); continue; } r -= I_UP;
        { const int kb = r / 32, nb = r % 32; tr_item(C.in[I_WDOWN] + (size_t)l * DFF * DM, DM, nullptr, C.wl(l, WL_WDOWN), DFF, kb * 64, nb * 32, nb * 32, scr, lane); }
    }
    for (int i = gw * 64 + lane; i < 2 * (INWP - INW) * DM / 8; i += NGW * 64) { const int l = i / ((INWP - INW) * DM / 8), j = i % ((INWP - INW) * DM / 8);
        unsigned z0 = 0u; asm volatile("" : "+v"(z0)); *((u32x4*)(C.wl(l, WL_WIN) + (size_t)INW * DM) + j) = (u32x4){z0, z0, z0, z0}; }
    for (int r = gw; r < 2 * DM; r += NGW) { const int l = r / DM, k = r % DM; const float gk = C.in[I_NMEMG][l * DM + k];
        const f32x4* src = (const f32x4*)(C.in[I_WQ] + (size_t)l * DM * DM + (size_t)k * DM); u32x2* dst = (u32x2*)((bf16*)(C.ws + WS_WQ) + (size_t)l * DM * DM + (size_t)k * DM);
#pragma unroll
        for (int j = 0; j < 4; ++j) { const f32x4 v = src[lane + 64 * j] * gk; u32x2 w; w.x = pk2(v[0], v[1]); w.y = pk2(v[2], v[3]); dst[lane + 64 * j] = w; } }
    for (int r = gw; r < TOK; r += NGW) { const f32x4* src = (const f32x4*)(C.in[I_X] + (size_t)r * DM); u32x2* dst = (u32x2*)((bf16*)(C.ws + WS_XB) + (size_t)r * DM); float s = 0.f;
#pragma unroll
        for (int j = 0; j < 4; ++j) { const f32x4 v = src[lane + 64 * j]; s += (v[0] * v[0] + v[1] * v[1]) + (v[2] * v[2] + v[3] * v[3]); u32x2 w; w.x = pk2(v[0], v[1]); w.y = pk2(v[2], v[3]); dst[lane + 64 * j] = w; }
        s = wave_sum(s); if (lane < 16) ((float*)(C.ws + WS_SSQ))[(size_t)r * 16 + lane] = lane == 0 ? s : 0.f; }
    for (int r = gw; r < MEMR; r += NGW) { const f32x4* src = (const f32x4*)(C.in[I_MEM] + (size_t)r * DM); const f32x4* gg = (const f32x4*)C.in[I_MEMG]; u32x2* dst = (u32x2*)((bf16*)(C.ws + WS_MEMN) + (size_t)r * DM);
        f32x4 v[4]; float s = 0.f;
#pragma unroll
        for (int j = 0; j < 4; ++j) { v[j] = src[lane + 64 * j]; s += (v[j][0] * v[j][0] + v[j][1] * v[j][1]) + (v[j][2] * v[j][2] + v[j][3] * v[j][3]); }
        const float rs = 1.0f / sqrtf(wave_sum(s) * (1.0f / DM) + EPS);
#pragma unroll
        for (int j = 0; j < 4; ++j) { const f32x4 o = v[j] * rs * gg[lane + 64 * j]; u32x2 w; w.x = pk2(o[0], o[1]); w.y = pk2(o[2], o[3]); dst[lane + 64 * j] = w; } }
    for (int i = C.bid * 512 + tid; i < 2 * 6 * 128 * 128; i += C.G * 512) ((bf16*)(C.ws + WS_WSB))[i] = (bf16)f2bf(C.in[I_WS][i]);
    for (int i = C.bid * 512 + tid; i < 2 * 4 * 64 * 64; i += C.G * 512) { const int lg = i >> 12, f = (i >> 6) & 63, e = i & 63; ((bf16*)(C.ws + WS_WPT))[i] = (bf16)f2bf(C.in[I_PW][(lg * 64 + e) * 64 + f]); }
    float* tab = (float*)(C.ws + WS_TAB);
    for (int i = C.bid * 512 + tid; i < 2 * INWP; i += C.G * 512) { const int l = i / INWP, c = i % INWP; tab[i] = c < INW ? C.in[I_BIN][l * INW + c] * ((c >= 1024 && c < 1408) ? QSCALE : 1.0f) : 0.f; }
    for (int i = C.bid * 512 + tid; i < 2 * DFF2; i += C.G * 512) { const int l = i / DFF2, c = i % DFF2; const int t = c >> 8, w = c & 255; const int src = w < 128 ? t * 128 + w : DFF + t * 128 + (w - 128);
        tab[2 * INWP + i] = C.in[I_BUP][l * DFF2 + src];
        float* cwp = (float*)(C.ws + WS_CWP) + (size_t)l * 4 * DFF2;
        cwp[c] = C.in[I_CW][(size_t)l * 3 * DFF2 + src]; cwp[DFF2 + c] = C.in[I_CW][(size_t)l * 3 * DFF2 + DFF2 + src]; cwp[2 * DFF2 + c] = C.in[I_CW][(size_t)l * 3 * DFF2 + 2 * DFF2 + src]; cwp[3 * DFF2 + c] = C.in[I_CB][(size_t)l * DFF2 + src]; }
}

__device__ __forceinline__ int t5_bucket(int rel) {
    const int n = rel < 0 ? -rel : rel; int b = rel > 0 ? 16 : 0;
    if (n < 8) return b + n;
    return b + 8 + (n >= 15) + (n >= 27) + (n >= 50) + (n >= 91) + (n >= 166) + (n >= 305) + (n >= 559);
}
namespace att {
typedef float f32x16 __attribute__((ext_vector_type(16)));
typedef short s16x4 __attribute__((ext_vector_type(4)));
typedef __bf16 bf16x2_t __attribute__((ext_vector_type(2)));
__device__ __forceinline__ unsigned cvtpk(float lo, float hi) { f32x2 v = {lo, hi}; bf16x2_t b = __builtin_convertvector(v, bf16x2_t); return __builtin_bit_cast(unsigned, b); }
__device__ __forceinline__ s16x4 vtr(const LAS unsigned char* p) { return __builtin_bit_cast(s16x4, __builtin_amdgcn_ds_read_tr16_b64_v4i16((LAS s16x4*)p)); }
constexpr int OFF_K = 0, OFF_V = 49152, OFF_WS = 98304, OFF_TAB = 102400;
template <bool MERGE>
__device__ __forceinline__ void unit(const Ctx& C, int g, int b, int h, int r, int blk) {
    const int lane = lane_id(), wid = C.wave, tid = lane + 64 * wid, r32 = lane & 31, hi = lane >> 5;
    const int d = 1 << (2 * g), L = SEQ >> (2 * g), q0 = blk * 256;
    const bf16* z = (const bf16*)(C.ws + WS_Z);
    const bf16* zb = z + ((size_t)b * SEQ + r) * INWP; const size_t rp = (size_t)d * INWP;
    const int colq = 1024 + g * 128 + h * 64, colk = 1408 + g * 128 + h * 64, colv = 1792 + g * 128 + h * 64;
    LAS unsigned char* lds = C.lds;
    LAS float* tabL = (LAS float*)(lds + OFF_TAB);
    if (tid < 255) { const int dl = tid - 127; float v = -3.0e38f; if (dl >= -64 && dl <= 64) v = C.in[I_REL][t5_bucket(dl * d) * 6 + g * 2 + h] * LOG2E; tabL[tid] = v; }
#pragma unroll
    for (int t = 0; t < 6; ++t) {
        int ki = q0 - 64 + 64 * t + lane; ki = ki < 0 ? 0 : (ki >= L ? L - 1 : ki);
        __builtin_amdgcn_global_load_lds((const unsigned*)(zb + (size_t)ki * rp + colk + wid * 8), (LAS unsigned*)(lds + OFF_K + t * 8192 + wid * 1024), 16, 0, 0);
        int vi = q0 - 64 + 64 * t + 16 * (wid & 3) + (lane >> 2); vi = vi < 0 ? 0 : (vi >= L ? L - 1 : vi);
        __builtin_amdgcn_global_load_lds((const unsigned*)(zb + (size_t)vi * rp + colv + (wid >> 2) * 32 + (lane & 3) * 8), (LAS unsigned*)(lds + OFF_V + t * 8192 + wid * 1024), 16, 0, 0);
    }
    bf16x8 qr[4];
    { const bf16* qp = zb + (size_t)(q0 + 32 * wid + r32) * rp + colq + hi * 8;
#pragma unroll
      for (int d0 = 0; d0 < 4; ++d0) qr[d0] = *(const GAS bf16x8*)(qp + d0 * 16); }
    asm volatile("s_waitcnt vmcnt(0)" ::: "memory"); __syncthreads();
    const int tb = wid >> 1;
    f32x16 S[3][2];
#pragma unroll
    for (int tt = 0; tt < 3; ++tt) {
        const LAS unsigned char* Ks = lds + OFF_K + (tb + tt) * 8192 + hi * 1024 + r32 * 16;
#pragma unroll
        for (int p = 0; p < 2; ++p)
#pragma unroll
            for (int i = 0; i < 16; ++i) S[tt][p][i] = 0.f;
#pragma unroll
        for (int d0 = 0; d0 < 4; ++d0) { const bf16x8 k0 = *(const LAS bf16x8*)(Ks + d0 * 2048), k1 = *(const LAS bf16x8*)(Ks + d0 * 2048 + 512);
            S[tt][0] = __builtin_amdgcn_mfma_f32_32x32x16_bf16(k0, qr[d0], S[tt][0], 0, 0, 0); S[tt][1] = __builtin_amdgcn_mfma_f32_32x32x16_bf16(k1, qr[d0], S[tt][1], 0, 0, 0); }
    }
    { const LAS float* tp = tabL + (4 * hi - r32 - 32 * (wid & 1) + 63);
      const bool edge = (blk == 0) || (q0 + 256 >= L); const int kb = q0 - 64 + 64 * tb + 4 * hi;
      float mx = -3.0e38f;
#pragma unroll
      for (int tt = 0; tt < 3; ++tt)
#pragma unroll
          for (int p = 0; p < 2; ++p)
#pragma unroll
              for (int i = 0; i < 16; ++i) { const int cr = 64 * tt + 32 * p + (i & 3) + 8 * (i >> 2); float v = S[tt][p][i] + tp[cr];
                  if (edge) { const int kidx = kb + cr; if (kidx < 0 || kidx >= L) v = -3.0e38f; }
                  S[tt][p][i] = v; mx = fmaxf(mx, v); }
      mx = xmax32(mx);
      float l = 0.f;
#pragma unroll
      for (int tt = 0; tt < 3; ++tt)
#pragma unroll
          for (int p = 0; p < 2; ++p)
#pragma unroll
              for (int i = 0; i < 16; ++i) { const float e = __builtin_amdgcn_exp2f(S[tt][p][i] - mx); S[tt][p][i] = e; l += e; }
      l = xsum32(l);
      LAS float* wsf = (LAS float*)(lds + OFF_WS) + wid * 128;
      const int tokq = b * SEQ + r + d * (q0 + 32 * wid + r32);
      if (!MERGE) { if (hi == 0) { wsf[r32] = 1.0f / l; ((float*)(C.ws + WS_LSE))[((size_t)(g - 1) * TOK + tokq) * 2 + h] = mx + __builtin_amdgcn_logf(l); } }
      else if (hi == 0) { const float* lse = (const float*)(C.ws + WS_LSE); const float l0 = mx + __builtin_amdgcn_logf(l), l1 = lse[(size_t)tokq * 2 + h], l2 = lse[((size_t)TOK + tokq) * 2 + h];
          const float M = fmaxf(fmaxf(l0, l1), l2); const float w0 = __builtin_amdgcn_exp2f(l0 - M), w1 = __builtin_amdgcn_exp2f(l1 - M), w2 = __builtin_amdgcn_exp2f(l2 - M); const float iw = 1.0f / (w0 + w1 + w2);
          wsf[r32] = w0 * iw / l; wsf[32 + r32] = w1 * iw; wsf[64 + r32] = w2 * iw; }
    }
    f32x16 o[2];
#pragma unroll
    for (int i = 0; i < 16; ++i) { o[0][i] = 0.f; o[1][i] = 0.f; }
    { const LAS unsigned char* vp0 = lds + OFF_V + ((lane >> 4) & 1) * 32 + (lane & 3) * 8 + (4 * hi + ((lane & 15) >> 2)) * 64;
#pragma unroll
      for (int tt = 0; tt < 3; ++tt) { const LAS unsigned char* vt = vp0 + (tb + tt) * 8192;
#pragma unroll
          for (int ks = 0; ks < 4; ++ks) { const f32x16& P = S[tt][ks >> 1]; const int rb = (ks & 1) * 8;
              u32x4 pw; pw.x = cvtpk(P[rb + 0], P[rb + 1]); pw.y = cvtpk(P[rb + 2], P[rb + 3]); pw.z = cvtpk(P[rb + 4], P[rb + 5]); pw.w = cvtpk(P[rb + 6], P[rb + 7]);
              const bf16x8 pa = __builtin_bit_cast(bf16x8, pw);
#pragma unroll
              for (int dh = 0; dh < 2; ++dh) { const s16x4 lo = vtr(vt + dh * 4096 + ks * 1024), hi4 = vtr(vt + dh * 4096 + ks * 1024 + 512);
                  const bf16x8 vf = (bf16x8){lo[0], lo[1], lo[2], lo[3], hi4[0], hi4[1], hi4[2], hi4[3]};
                  o[dh] = __builtin_amdgcn_mfma_f32_32x32x16_bf16(pa, vf, o[dh], 0, 0, 0); } } }
    }
    asm volatile("s_waitcnt lgkmcnt(0)" ::: "memory"); __syncthreads();
    { LAS float* stg = (LAS float*)(lds + wid * 8192); const LAS float* wsf = (const LAS float*)(lds + OFF_WS) + wid * 128;
#pragma unroll
      for (int i = 0; i < 16; ++i) { const int q = (i & 3) + 8 * (i >> 2) + 4 * hi; stg[q * 64 + r32] = o[0][i]; stg[q * 64 + 32 + r32] = o[1][i]; }
      asm volatile("s_waitcnt lgkmcnt(0)" ::: "memory");
#pragma unroll
      for (int it = 0; it < 4; ++it) { const int row = it * 8 + (lane >> 3), ch = lane & 7; const size_t tok = (size_t)b * SEQ + r + (size_t)d * (q0 + 32 * wid + row);
          const f32x4 a0 = *(const LAS f32x4*)(stg + row * 64 + ch * 8), a1 = *(const LAS f32x4*)(stg + row * 64 + ch * 8 + 4); const float c0 = wsf[row];
          float v[8] = {a0[0] * c0, a0[1] * c0, a0[2] * c0, a0[3] * c0, a1[0] * c0, a1[1] * c0, a1[2] * c0, a1[3] * c0};
          if (MERGE) { const bf16* og = (const bf16*)(C.ws + WS_OG); const float c1 = wsf[32 + row], c2 = wsf[64 + row];
              const u32x4 x1 = *(const GAS u32x4*)(og + tok * 128 + h * 64 + ch * 8), x2 = *(const GAS u32x4*)(og + ((size_t)TOK + tok) * 128 + h * 64 + ch * 8);
#pragma unroll
              for (int e = 0; e < 4; ++e) { v[2 * e] += c1 * bflo(x1[e]) + c2 * bflo(x2[e]); v[2 * e + 1] += c1 * bfhi(x1[e]) + c2 * bfhi(x2[e]); } }
          u32x4 w; w.x = cvtpk(v[0], v[1]); w.y = cvtpk(v[2], v[3]); w.z = cvtpk(v[4], v[5]); w.w = cvtpk(v[6], v[7]);
          if (MERGE) *(GAS u32x4*)((bf16*)(C.ws + WS_Y) + tok * OUTW + 640 + h * 64 + ch * 8) = w;
          else *(GAS u32x4*)((bf16*)(C.ws + WS_OG) + ((size_t)(g - 1) * TOK + tok) * 128 + h * 64 + ch * 8) = w; }
    }
    asm volatile("s_waitcnt lgkmcnt(0)" ::: "memory"); __syncthreads();
}
}
__device__ __forceinline__ void phase_attn12(const Ctx& C) {
    for (int u = C.bid; u < 256; u += C.G) {
        if (u < 128) att::unit<false>(C, 1, u >> 5, (u >> 4) & 1, (u >> 2) & 3, u & 3);
        else { const int v = u - 128; att::unit<false>(C, 2, v >> 5, (v >> 4) & 1, v & 15, 0); }
    }
}

__device__ __forceinline__ void unpack8(const u32x4 v, float (&f)[8]) {
#pragma unroll
    for (int e = 0; e < 4; ++e) { f[2 * e] = bflo(v[e]); f[2 * e + 1] = bfhi(v[e]); }
}
__device__ __forceinline__ void gmlp_unit(const Ctx& C, int l, int b, int n, int h) {
    const int lane = lane_id(), wid = C.wave, tid = lane + 64 * wid, fr = lane & 15, fq = lane >> 4;
    const bf16* z = (const bf16*)(C.ws + WS_Z); bf16* y = (bf16*)(C.ws + WS_Y);
    const size_t r0 = (size_t)b * SEQ + n * 128;
    LAS bf16* vnT = (LAS bf16*)C.lds;
    { const int q = tid >> 2, part = tid & 3; const bf16* src = z + (r0 + q) * INWP + 384 + h * 64 + part * 16;
      const u32x4 a = *(const GAS u32x4*)src, bq = *(const GAS u32x4*)(src + 8);
      float v[16]; { float t0[8], t1[8]; unpack8(a, t0); unpack8(bq, t1);
#pragma unroll
          for (int j = 0; j < 8; ++j) { v[j] = gelu_tanh(t0[j]); v[8 + j] = gelu_tanh(t1[j]); } }
      float ss = 0.f;
#pragma unroll
      for (int j = 0; j < 16; ++j) ss += v[j] * v[j];
      ss += xshf<1>(ss); ss += xshf<2>(ss);
      const float rs = 1.0f / sqrtf(ss * (1.0f / 64) + EPS);
      const float* vg = C.in[I_VG] + (l * 6 + h) * 64 + part * 16;
#pragma unroll
      for (int j = 0; j < 16; ++j) vnT[(part * 16 + j) * 136 + q] = (bf16)f2bf(v[j] * rs * vg[j]); }
    asm volatile("s_waitcnt lgkmcnt(0)" ::: "memory"); __syncthreads();
    const bf16* wsb = (const bf16*)(C.ws + WS_WSB) + ((size_t)(l * 6 + h) * 128 + 16 * wid + fr) * 128 + fq * 8;
    bf16x8 bfr[4];
#pragma unroll
    for (int ks = 0; ks < 4; ++ks) bfr[ks] = *(const GAS bf16x8*)(wsb + ks * 32);
    f32x4 acc[4];
#pragma unroll
    for (int m = 0; m < 4; ++m) { acc[m] = (f32x4){0.f, 0.f, 0.f, 0.f};
#pragma unroll
        for (int ks = 0; ks < 4; ++ks) { const bf16x8 af = *(const LAS bf16x8*)(vnT + (16 * m + fr) * 136 + ks * 32 + fq * 8); acc[m] = __builtin_amdgcn_mfma_f32_16x16x32_bf16(af, bfr[ks], acc[m], 0, 0, 0); } }
    const int p = 16 * wid + fr; const float bsv = C.in[I_BS][(l * 6 + h) * 128 + p];
#pragma unroll
    for (int m = 0; m < 4; ++m) { const int e0 = 16 * m + 4 * fq; const u32x2 zu = *(const GAS u32x2*)(z + (r0 + p) * INWP + h * 64 + e0);
        const float u0 = gelu_tanh(bflo(zu.x)), u1 = gelu_tanh(bfhi(zu.x)), u2 = gelu_tanh(bflo(zu.y)), u3 = gelu_tanh(bfhi(zu.y));
        u32x2 w; w.x = pk2(u0 * (acc[m][0] + bsv), u1 * (acc[m][1] + bsv)); w.y = pk2(u2 * (acc[m][2] + bsv), u3 * (acc[m][3] + bsv));
        *(GAS u32x2*)(y + (r0 + p) * OUTW + h * 64 + e0) = w; }
    __syncthreads();
}
__device__ __forceinline__ void pool_unit(const Ctx& C, int l, int uu) {
    const int lane = lane_id(), wid = C.wave, tid = lane + 64 * wid, fr = lane & 15, fq = lane >> 4;
    const bf16* z = (const bf16*)(C.ws + WS_Z); bf16* y = (bf16*)(C.ws + WS_Y);
    const int r0 = uu * 64, pos0 = r0 & (SEQ - 1), base = r0 - pos0;
    LAS unsigned char* zt = C.lds + 32768;
    LAS unsigned char* pl = zt + 43008;
    for (int i = tid; i < 80 * 32; i += 512) { const int rr = i >> 5, c = i & 31, pos = pos0 - 8 + rr; unsigned z0 = 0u; asm volatile("" : "+v"(z0)); u32x4 v = (u32x4){z0, z0, z0, z0};
        if (pos >= 0 && pos < SEQ) v = *(const GAS u32x4*)(z + (size_t)(base + pos) * INWP + 768 + c * 8);
        *(LAS u32x4*)(zt + rr * 528 + c * 16) = v; }
    asm volatile("s_waitcnt lgkmcnt(0)" ::: "memory"); __syncthreads();
    for (int i = tid; i < 64 * 32; i += 512) { const int t = i >> 5, c = i & 31, g = c >> 3, hw = 1 << g, pos = pos0 + t;
        const int lo = pos - hw < 0 ? 0 : pos - hw, hi = pos + hw > SEQ ? SEQ : pos + hw;
        float sacc[8];
#pragma unroll
        for (int e = 0; e < 8; ++e) sacc[e] = 0.f;
        for (int p = lo; p < hi; ++p) { float f[8]; unpack8(*(const LAS u32x4*)(zt + (p - pos0 + 8) * 528 + c * 16), f);
#pragma unroll
            for (int e = 0; e < 8; ++e) sacc[e] += f[e]; }
        float own[8]; unpack8(*(const LAS u32x4*)(zt + (t + 8) * 528 + c * 16), own); const float inv = 1.0f / (float)(hi - lo);
        u32x4 w; w.x = pk2(sacc[0] * inv - own[0], sacc[1] * inv - own[1]); w.y = pk2(sacc[2] * inv - own[2], sacc[3] * inv - own[3]);
        w.z = pk2(sacc[4] * inv - own[4], sacc[5] * inv - own[5]); w.w = pk2(sacc[6] * inv - own[6], sacc[7] * inv - own[7]);
        *(LAS u32x4*)(pl + t * 528 + c * 16) = w; }
    asm volatile("s_waitcnt lgkmcnt(0)" ::: "memory"); __syncthreads();
    const int g = wid >> 1; const bf16* wpt = (const bf16*)(C.ws + WS_WPT) + (size_t)(l * 4 + g) * 4096;
    bf16x8 af[4][2];
#pragma unroll
    for (int m = 0; m < 4; ++m)
#pragma unroll
        for (int ks = 0; ks < 2; ++ks) af[m][ks] = *(const GAS bf16x8*)(wpt + (16 * m + fr) * 64 + ks * 32 + fq * 8);
    const float* pb = C.in[I_PB] + l * 256 + g * 64; const float* psc = C.in[I_PSC] + l * 256 + g * 64;
#pragma unroll
    for (int nt = 0; nt < 2; ++nt) { const int tN = ((wid & 1) * 2 + nt) * 16;
        f32x4 acc[4];
#pragma unroll
        for (int m = 0; m < 4; ++m) acc[m] = (f32x4){0.f, 0.f, 0.f, 0.f};
#pragma unroll
        for (int ks = 0; ks < 2; ++ks) { const bf16x8 bfg = *(const LAS bf16x8*)(pl + (tN + fr) * 528 + (g * 64 + ks * 32 + fq * 8) * 2);
#pragma unroll
            for (int m = 0; m < 4; ++m) acc[m] = __builtin_amdgcn_mfma_f32_16x16x32_bf16(af[m][ks], bfg, acc[m], 0, 0, 0); }
#pragma unroll
        for (int m = 0; m < 4; ++m) { const int f0 = 16 * m + 4 * fq; const f32x4 bb = *(const GAS f32x4*)(pb + f0), sc = *(const GAS f32x4*)(psc + f0); const f32x4 o = (acc[m] + bb) * sc;
            u32x2 w; w.x = pk2(o[0], o[1]); w.y = pk2(o[2], o[3]); *(GAS u32x2*)(y + (size_t)(r0 + tN + fr) * OUTW + 384 + g * 64 + f0) = w; } }
    __syncthreads();
}
__device__ __forceinline__ void phase_mixer(const Ctx& C, int l) {
    for (int uu = C.bid; uu < NBATCH * 32 * 6; uu += C.G) gmlp_unit(C, l, uu / 192, (uu / 6) % 32, uu % 6);
    for (int uu = C.bid; uu < TOK / 64; uu += C.G) pool_unit(C, l, uu);
    for (int u = C.bid; u < 128; u += C.G) att::unit<true>(C, 0, u >> 5, (u >> 4) & 1, 0, u & 15);
}

__device__ __forceinline__ void fix_rows(const Ctx& C, int l, int pm) {
    const float* uh = (const float*)(C.ws + WS_UH); const float* cwp = (const float*)(C.ws + WS_CWP) + (size_t)l * 4 * DFF2; bf16* G = (bf16*)(C.ws + WS_G);
    const int seqt = pm & 15;
    const int tid = lane_id() + 64 * C.wave;
    for (int i = tid; i < 2 * (DFF / 8); i += 512) {
        const int rsel = i / (DFF / 8), c8 = (i % (DFF / 8)) * 8; const int t = c8 >> 7, w = c8 & 127, cu = t * 256 + w;
        if (rsel == 0 ? seqt == 0 : seqt == 15) continue;
        const float* up = rsel == 0 ? uh + (size_t)((pm - 1) * 4 + 3) * DFF2 : uh + (size_t)(pm * 4 + 2) * DFF2;
        const float* cur = rsel == 0 ? uh + (size_t)(pm * 4 + 0) * DFF2 : uh + (size_t)(pm * 4 + 3) * DFF2;
        const float* dn = rsel == 0 ? uh + (size_t)(pm * 4 + 1) * DFF2 : uh + (size_t)((pm + 1) * 4 + 0) * DFF2;
        float o[8];
#pragma unroll
        for (int hlf = 0; hlf < 2; ++hlf) { const int cg = cu + 4 * hlf, cvv = cu + 128 + 4 * hlf;
            const f32x4 gu = *(const GAS f32x4*)(up + cg), gc = *(const GAS f32x4*)(cur + cg), gd = *(const GAS f32x4*)(dn + cg);
            const f32x4 vu = *(const GAS f32x4*)(up + cvv), vc = *(const GAS f32x4*)(cur + cvv), vd = *(const GAS f32x4*)(dn + cvv);
            const f32x4 a0 = *(const GAS f32x4*)(cwp + cg), a1 = *(const GAS f32x4*)(cwp + DFF2 + cg), a2 = *(const GAS f32x4*)(cwp + 2 * DFF2 + cg), ab = *(const GAS f32x4*)(cwp + 3 * DFF2 + cg);
            const f32x4 b0 = *(const GAS f32x4*)(cwp + cvv), b1 = *(const GAS f32x4*)(cwp + DFF2 + cvv), b2 = *(const GAS f32x4*)(cwp + 2 * DFF2 + cvv), bb = *(const GAS f32x4*)(cwp + 3 * DFF2 + cvv);
#pragma unroll
            for (int e = 0; e < 4; ++e) { const float gt = (a0[e] * gu[e] + a1[e] * gc[e]) + (a2[e] * gd[e] + ab[e]); const float vl = (b0[e] * vu[e] + b1[e] * vc[e]) + (b2[e] * vd[e] + bb[e]);
                o[4 * hlf + e] = gt / (1.0f + __builtin_amdgcn_exp2f(-LOG2E * gt)) * vl; } }
        u32x4 w4; w4.x = pk2(o[0], o[1]); w4.y = pk2(o[2], o[3]); w4.z = pk2(o[4], o[5]); w4.w = pk2(o[6], o[7]);
        *(GAS u32x4*)(G + (size_t)(pm * 256 + (rsel ? 255 : 0)) * DFF + c8) = w4;
    }
    asm volatile("s_waitcnt vmcnt(0)" ::: "memory"); __syncthreads();
}

__device__ __forceinline__ void phase_final(const Ctx& C) {
    const int gw = C.bid * 8 + C.wave, NGW = C.G * 8, lane = lane_id(); const f32x4* gg = (const f32x4*)C.in[I_FNG];
    for (int r = gw; r < TOK; r += NGW) { f32x4* xr = (f32x4*)(C.out + (size_t)r * DM); f32x4 v[4]; float s = 0.f;
#pragma unroll
        for (int j = 0; j < 4; ++j) { v[j] = xr[lane + 64 * j]; s += (v[j][0] * v[j][0] + v[j][1] * v[j][1]) + (v[j][2] * v[j][2] + v[j][3] * v[j][3]); }
        const float rs = 1.0f / sqrtf(wave_sum(s) * (1.0f / DM) + EPS);
#pragma unroll
        for (int j = 0; j < 4; ++j) xr[lane + 64 * j] = v[j] * rs * gg[lane + 64 * j]; }
}

__device__ __forceinline__ int probe_reps(int ph) {
    if (PROBE_KIND == 0) return 1;
    const int lph = ph >= PH_L0 && ph < PH_FINAL ? (ph - PH_L0) % PH_PER_LAYER : -1;
    bool m = false;
    if (PROBE_KIND == 1) m = lph == 2;
    if (PROBE_KIND == 3) m = lph == 6;
    if (PROBE_KIND == 4) m = lph == 0;
    if (PROBE_KIND == 5) m = ph == PH_PRO;
    if (PROBE_KIND == 6) m = lph == 4;
    if (PROBE_KIND == 8) m = lph == 1;
    return m ? 2 : 1;
}
__global__ void __launch_bounds__(512, 2) enc_fwd(Args args) {
    extern __shared__ __attribute__((aligned(16))) unsigned char lds_raw[];
    LAS unsigned char* const lds0 = (LAS unsigned char*)lds_raw;
    volatile LAS unsigned* MISC = (volatile LAS unsigned*)(lds0 + MISC_OFF);
    for (int u = threadIdx.x; u < (LDS_BYTES - LDSCTL_OFF) / 4; u += 512) ((LAS unsigned*)(lds0 + LDSCTL_OFF))[u] = 0u;
    __syncthreads();
    XcdBarrier bar; bar.bar = (unsigned*)(args.ws + WS_CTL) + 4096; bar.x = 0; bar.st = nullptr;
    const int lo = args.ph_lo, hi = args.ph_hi;
    const int wave_s = __builtin_amdgcn_readfirstlane(threadIdx.x >> 6);
    if (hi - lo > 1) bar = xcd_barrier_post((unsigned*)(args.ws + WS_CTL) + 4096, MISC + 8);

    for (int ph = lo; ph < hi; ++ph)
    for (int rep = 0; rep < probe_reps(ph); ++rep) {
        if (ph > lo || rep > 0) { XcdBarrier b2 = bar; asm volatile("" : "+s"(b2.bar), "+s"(b2.x)); xcd_barrier(b2); }
        unsigned char* ws_ = args.ws; asm volatile("" : "+s"(ws_));
        float* out_ = args.out; asm volatile("" : "+s"(out_));
        int wv_ = wave_s, bid_ = blockIdx.x, G_ = gridDim.x; asm volatile("" : "+s"(wv_), "+s"(bid_), "+s"(G_));
        Ctx C; C.lds = lds0; C.wave = wv_; C.G = G_; C.bid = bid_;
        C.in = args.in; C.out = out_; C.ws = ws_;
        LAS unsigned char* ring = C.lds; LAS unsigned char* xl = C.lds + XL_OFF;
        const int G = C.G, bid = C.bid;
        float* ssq = (float*)(C.ws + WS_SSQ); const float* tab = (const float*)(C.ws + WS_TAB);
        bf16* xb = (bf16*)(C.ws + WS_XB);
        if (ph == PH_PRO) { phase_prologue(C); continue; }
        if (ph == PH_FINAL) { phase_final(C); continue; }
        const int lph = (ph - PH_L0) % PH_PER_LAYER, l = (ph - PH_L0) / PH_PER_LAYER;
        if (lph == 1) phase_attn12(C);
        if (lph == 2) { phase_mixer(C, l); continue; }
        if (lph == 7) { for (int pm = bid; pm < 64; pm += G) fix_rows(C, l, pm); continue; }
        int njobs = 1; if (l == 0 && lph == 0) njobs = 3; if (l == 0 && lph == 1) njobs = 4; if (l != 0 && lph == 1) njobs = 0;
        for (int job = 0; job < njobs; ++job) {
            int kind = 0; pg8::Gemm g{}; pg8::StaticOrder S{}; pg8::EpiP EP{};
            if (lph == 0 && job == 0) {
                g.A = xb; g.Bt = C.wl(l, WL_WIN); g.K = DM; g.lda = DM; g.ldb = DM; g.ma = pg8::map_rows(DM); g.mb = pg8::map_cols(DM);
                S.init(64, 9, G, bid); kind = 0; EP = pg8::EpiP{(void*)((bf16*)(C.ws + WS_Z)), tab + l * INWP, ssq, nullptr, nullptr, INWP, 1.0f};
            } else if (lph == 0) {
                const int ll = job - 1;
                g.A = (const bf16*)(C.ws + WS_MEMN); g.Bt = (const bf16*)(C.ws + WS_WKVT) + (size_t)ll * 2048 * DM; g.K = DM; g.lda = DM; g.ldb = DM; g.ma = pg8::map_rows(DM); g.mb = pg8::map_cols(DM);
                S.init(4, 8, G, (bid + G - 64 - 32 * ll) % G);
                kind = 0; EP = pg8::EpiP{(void*)((bf16*)(C.ws + WS_KV) + (size_t)ll * MEMR * 2048), nullptr, nullptr, nullptr, nullptr, 2048, 1.0f};
            } else if (lph == 1) {
                const int ll = job >> 1; const bf16* KV = (const bf16*)(C.ws + WS_KV) + (size_t)ll * MEMR * 2048;
                if ((job & 1) == 0) {
                    g.A = KV; g.lda = 2048; g.ma = pg8::OpMap{2, 3, 0, 0, 256 * 2048, 256, 0, 0};
                    g.Bt = (const bf16*)(C.ws + WS_WQ) + (size_t)ll * DM * DM; g.ldb = DM; g.mb = pg8::OpMap{0, 3, 0, 0, 0, 256, 256 * DM, 0}; g.K = 256;
                    S.init(16, 4, G, (bid + G - 64 * job) % G);
                    kind = 0; EP = pg8::EpiP{(void*)(C.wl(ll, WL_QKT)), nullptr, nullptr, nullptr, nullptr, DM, 0.0625f * LOG2E};
                } else {
                    g.A = (const bf16*)(C.ws + WS_WOT) + (size_t)ll * DM * DM; g.lda = DM; g.ma = pg8::OpMap{0, 0, 0, 3, 256 * DM, 0, 0, 256};
                    g.Bt = KV + 1024; g.ldb = 2048; g.mb = pg8::OpMap{0, 0, 2, 3, 0, 0, 256 * 2048, 256}; g.K = 256;
                    S.init(4, 16, G, (bid + G - 64 * job) % G);
                    kind = 0; EP = pg8::EpiP{(void*)(C.wl(ll, WL_VOT)), nullptr, nullptr, nullptr, nullptr, 4096, 1.0f};
                }
            } else if (lph == 3) {
                g.A = (const bf16*)(C.ws + WS_Y); g.Bt = C.wl(l, WL_WOUT); g.K = OUTW; g.lda = OUTW; g.ldb = OUTW; g.ma = pg8::map_rows(OUTW); g.mb = pg8::map_cols(OUTW);
                S.init(64, 4, G, bid); kind = 2; EP = pg8::EpiP{(void*)xb, C.in[I_BOUT] + l * DM, ssq, l == 0 ? C.in[I_X] : C.out, (void*)C.out, 0, 1.0f};
            } else if (lph == 4) {
                g.A = xb; g.Bt = C.wl(l, WL_QKT); g.K = DM; g.lda = DM; g.ldb = DM; g.ma = pg8::map_rows(DM); g.mb = pg8::OpMap{4, 0, 0, 0, 1024 * 1024, 0, 256 * DM, 0};
                S.init(64, 4, G, bid); kind = 1; EP = pg8::EpiP{(void*)(C.ws + WS_P), nullptr, ssq, nullptr, nullptr, 0, 1.0f};
            } else if (lph == 5) {
                g.A = (const bf16*)(C.ws + WS_P); g.Bt = C.wl(l, WL_VOT); g.K = DM; g.lda = DM; g.ldb = 4096; g.ma = pg8::map_rows(DM); g.mb = pg8::OpMap{4, 0, 0, 0, 1024, 0, 256 * 4096, 0};
                S.init(64, 4, G, bid); kind = 2; EP = pg8::EpiP{(void*)xb, C.in[I_BO] + l * DM, ssq, C.out, (void*)C.out, 0, 1.0f};
            } else if (lph == 6) {
                g.A = xb; g.Bt = C.wl(l, WL_WUP); g.K = DM; g.lda = DM; g.ldb = DM; g.ma = pg8::map_rows(DM); g.mb = pg8::map_cols(DM);
                S.init(64, 22, G, bid); kind = 3; EP = pg8::EpiP{(void*)(C.ws + WS_G), tab + 2 * INWP + l * DFF2, ssq, (const float*)(C.ws + WS_CWP) + (size_t)l * 4 * DFF2, (void*)(C.ws + WS_UH), 0, 1.0f};
            } else {
                g.A = (const bf16*)(C.ws + WS_G); g.Bt = C.wl(l, WL_WDOWN); g.K = DFF; g.lda = DFF; g.ldb = DFF; g.ma = pg8::map_rows(DFF); g.mb = pg8::map_cols(DFF);
                S.init(64, 4, G, bid); kind = 2; EP = pg8::EpiP{(void*)xb, C.in[I_BDOWN] + l * DM, ssq, C.out, (void*)C.out, 0, 1.0f};
            }
            if (kind == 0) pg8::gemm_phase<pg8::EpiRowBf16, pg8::StaticOrder>(ring, xl, g, S, pg8::EpiRowBf16{EP}, C.wave);
            else if (kind == 1) pg8::gemm_phase<pg8::EpiSoftmax, pg8::StaticOrder>(ring, xl, g, S, pg8::EpiSoftmax{EP}, C.wave);
            else if (kind == 2) pg8::gemm_phase<pg8::EpiResidual, pg8::StaticOrder>(ring, xl, g, S, pg8::EpiResidual{EP}, C.wave);
            else pg8::gemm_phase<pg8::EpiConvGate, pg8::StaticOrder>(ring, xl, g, S, pg8::EpiConvGate{EP}, C.wave);
        }
    }
}

extern "C" void kernel_launch(void* const* d_in, const int* in_sizes, int n_in, void* d_out, int out_size, void* d_ws, size_t ws_size, hipStream_t stream) {
    static int grid = 0;
    if (grid == 0) {
        if (n_in != N_IN || in_sizes[0] != TOK * DM || out_size != TOK * DM || ws_size < 256 * MiB) { fprintf(stderr, "kernel_launch: unexpected shapes (n_in %d, in0 %d, out %d, ws %zu)\n", n_in, n_in > 0 ? in_sizes[0] : -1, out_size, ws_size); grid = -1; return; }
        int dev = 0, cus = 0, per_cu = 0;
        if (hipGetDevice(&dev) != hipSuccess || hipDeviceGetAttribute(&cus, hipDeviceAttributeMultiprocessorCount, dev) != hipSuccess) { grid = -1; return; }
        if (hipFuncSetAttribute((const void*)enc_fwd, hipFuncAttributeMaxDynamicSharedMemorySize, LDS_BYTES) != hipSuccess) { fprintf(stderr, "kernel_launch: hipFuncSetAttribute failed\n"); grid = -1; return; }
        if (hipOccupancyMaxActiveBlocksPerMultiprocessor(&per_cu, (const void*)enc_fwd, 512, LDS_BYTES) != hipSuccess || per_cu < 1) fprintf(stderr, "kernel_launch: occupancy query says %d\n", per_cu);
        (void)hipGetLastError();
        grid = cus;
    }
    if (grid < 0) return;
    if (hipMemsetAsync((char*)d_ws + WS_CTL, 0, CTL_ZERO_BYTES, stream) != hipSuccess) return;
    Args a{};
    for (int i = 0; i < N_IN; ++i) a.in[i] = (const float*)d_in[i];
    a.out = (float*)d_out; a.ws = (unsigned char*)d_ws;
#if MK_PER_PHASE
    for (int ph = 0; ph < N_PHASES; ++ph) { a.ph_lo = ph; a.ph_hi = ph + 1; hipLaunchKernelGGL(enc_fwd, dim3(grid), dim3(512), LDS_BYTES, stream, a); }
#else
    a.ph_lo = 0; a.ph_hi = N_PHASES; hipLaunchKernelGGL(enc_fwd, dim3(grid), dim3(512), LDS_BYTES, stream, a);
#endif
}
```
